# Optimizing an MI355X kernel written in HIP

```python
import math
import jax, jax.numpy as jnp
from jax import lax
import numpy as np

D_MODEL = 2048
BATCH = 1
SEQ = 8192
DEPTH = 2
DEC_BATCH = 8
DEC_SEQ = 32
PAST_LEN = 1024

CHUNK = 64
Q_BLOCK = 128
H_A = 4
DH_A = 128
DV_A = 2 * DH_A
H_B = 8
DH_B = 128
D_FF = 5632
ROPE_THETA = 10000.0
EPS = 1e-6
NEG_INF = -1e30
A_QK = 2 * H_A * DH_A
A_V = H_A * DV_A
B_QKV = H_B * DH_B
N_IN = 2 * A_QK + A_V + 3 * B_QKV + 2 * D_MODEL

kernel_name = "streaming_diffattn_stickbreak_hybrid_step"


def _rmsnorm(x, g):
    xf = x.astype(jnp.float32)
    y = xf * lax.rsqrt(jnp.mean(xf * xf, axis=-1, keepdims=True) + EPS)
    return (y * g.astype(jnp.float32)).astype(x.dtype)


def _rope(x, pos):
    d = x.shape[-1]
    inv = 1.0 / (ROPE_THETA ** (jnp.arange(0, d, 2, dtype=jnp.float32) / d))
    ang = pos.astype(jnp.float32)[:, None] * inv[None, :]
    cos = jnp.cos(ang)[None, :, None, :]
    sin = jnp.sin(ang)[None, :, None, :]
    xf = x.astype(jnp.float32)
    x1, x2 = xf[..., : d // 2], xf[..., d // 2:]
    return jnp.concatenate([x1 * cos - x2 * sin, x2 * cos + x1 * sin], axis=-1).astype(x.dtype)


def _swiglu_half(x, g, wg, wu, wd):
    h = _rmsnorm(x, g)
    return x + 0.5 * ((jax.nn.silu(h @ wg) * (h @ wu)) @ wd)


def _query_blocked(fn, q_pos, q):
    b, sq = q.shape[0], q.shape[1]
    qb = Q_BLOCK if sq % Q_BLOCK == 0 else sq
    nb = sq // qb
    if nb == 1:
        return fn((q_pos, q))
    qr = jnp.swapaxes(q.reshape(b, nb, qb, *q.shape[2:]), 0, 1)
    out = lax.map(fn, (q_pos.reshape(nb, qb), qr))
    out = jnp.swapaxes(out, 0, 1)
    return out.reshape(b, sq, *out.shape[3:])


def _diff_attention(q, k, v, q_pos, k_pos, lam):
    scale = DH_A ** -0.5

    def block(args):
        qp, qb = args
        s = jnp.einsum('bqhd,bkhd->bhqk', qb, k, preferred_element_type=jnp.float32) * scale
        mask = (k_pos[None, :] // CHUNK) <= (qp[:, None] // CHUNK)
        p = jax.nn.softmax(jnp.where(mask, s, NEG_INF), axis=-1)
        p = p.reshape(p.shape[0], H_A, 2, p.shape[2], p.shape[3])
        w = p[:, :, 0] - lam * p[:, :, 1]
        return jnp.einsum('bhqk,bkhe->bqhe', w.astype(v.dtype), v)

    return _query_blocked(block, q_pos, q)


def _stick_breaking(q, k, v, q_pos, k_pos):
    scale = DH_B ** -0.5

    def block(args):
        qp, qb = args
        z = jnp.einsum('bqhd,bkhd->bhqk', qb, k, preferred_element_type=jnp.float32) * scale
        mask = k_pos[None, :] < qp[:, None]
        log_keep = jnp.where(mask, jax.nn.log_sigmoid(-z), 0.0)
        after = lax.cumsum(log_keep, axis=3, reverse=True) - log_keep
        a = jnp.where(mask, jnp.exp(jax.nn.log_sigmoid(z) + after), 0.0)
        return jnp.einsum('bhqk,bkhd->bqhd', a.astype(v.dtype), v)

    return _query_blocked(block, q_pos, q)


def _mixer(x, pos, past, li, p):
    b, s, _ = x.shape
    h = _rmsnorm(x, p['mix_norm'])
    proj = h @ p['w_in']
    o1 = A_QK
    o2 = o1 + A_QK
    o3 = o2 + A_V
    o4 = o3 + B_QKV
    o5 = o4 + B_QKV
    o6 = o5 + B_QKV
    o7 = o6 + D_MODEL
    qa, ka, va, qb, kb, vb, ga, gb = jnp.split(proj, [o1, o2, o3, o4, o5, o6, o7], axis=-1)
    qa = _rope(_rmsnorm(qa.reshape(b, s, 2 * H_A, DH_A), p['a_q_norm']), pos)
    ka = _rope(_rmsnorm(ka.reshape(b, s, 2 * H_A, DH_A), p['a_k_norm']), pos)
    va = va.reshape(b, s, H_A, DV_A)
    qb = qb.reshape(b, s, H_B, DH_B)
    kb = kb.reshape(b, s, H_B, DH_B)
    vb = vb.reshape(b, s, H_B, DH_B)
    if past is None:
        ka_all, va_all, kb_all, vb_all = ka, va, kb, vb
        k_pos = pos
    else:
        pk_a, pv_a, pk_b, pv_b = past
        ka_all = jnp.concatenate([pk_a, ka], axis=1)
        va_all = jnp.concatenate([pv_a, va], axis=1)
        kb_all = jnp.concatenate([pk_b, kb], axis=1)
        vb_all = jnp.concatenate([pv_b, vb], axis=1)
        k_pos = jnp.arange(pk_a.shape[1] + s)
    lam_init = 0.8 - 0.6 * math.exp(-0.3 * li)
    f32 = jnp.float32
    lam = (jnp.exp(jnp.sum(p['a_lam_q1'].astype(f32) * p['a_lam_k1'].astype(f32)))
           - jnp.exp(jnp.sum(p['a_lam_q2'].astype(f32) * p['a_lam_k2'].astype(f32)))
           + lam_init)
    oa = _diff_attention(qa, ka_all, va_all, pos, k_pos, lam)
    oa = (_rmsnorm(oa, p['a_sub_norm']) * (1.0 - lam_init)).reshape(b, s, A_V)
    ob = _stick_breaking(qb, kb_all, vb_all, pos, k_pos).reshape(b, s, B_QKV)
    merged = (jax.nn.sigmoid(ga) * (oa @ p['w_branch_a'])
              + jax.nn.sigmoid(gb) * (ob @ p['w_branch_b']))
    return x + merged @ p['w_out'], (ka, va, kb, vb)


def _layer(x, pos, past, li, p):
    x = _swiglu_half(x, p['ffn1_norm'], p['ffn1_w_gate'], p['ffn1_w_up'], p['ffn1_w_down'])
    x, rows = _mixer(x, pos, past, li, p)
    x = _swiglu_half(x, p['ffn2_norm'], p['ffn2_w_gate'], p['ffn2_w_up'], p['ffn2_w_down'])
    return x, rows


def setup_inputs(seed: int = 0) -> dict:
    key = jax.random.key(seed)
    ks = iter(jax.random.split(key, 32))

    def nrm(shape, scale):
        return jax.random.normal(next(ks), shape, jnp.float32) * scale

    def gain(shape):
        return 1.0 + 0.02 * jax.random.normal(next(ks), shape, jnp.float32)

    d, f = D_MODEL, D_FF
    return {
        'x_prompt': nrm((BATCH, SEQ, d), 1.0),
        'x_sample': nrm((DEC_BATCH, DEC_SEQ, d), 1.0),
        'cache_a_k': nrm((DEPTH, DEC_BATCH, PAST_LEN, 2 * H_A, DH_A), 1.0),
        'cache_a_v': nrm((DEPTH, DEC_BATCH, PAST_LEN, H_A, DV_A), 1.0),
        'cache_b_k': nrm((DEPTH, DEC_BATCH, PAST_LEN, H_B, DH_B), 1.0),
        'cache_b_v': nrm((DEPTH, DEC_BATCH, PAST_LEN, H_B, DH_B), 1.0),
        'ffn1_norm': gain((DEPTH, d)),
        'ffn1_w_gate': nrm((DEPTH, d, f), d ** -0.5),
        'ffn1_w_up': nrm((DEPTH, d, f), d ** -0.5),
        'ffn1_w_down': nrm((DEPTH, f, d), f ** -0.5),
        'mix_norm': gain((DEPTH, d)),
        'w_in': nrm((DEPTH, d, N_IN), d ** -0.5),
        'a_q_norm': gain((DEPTH, DH_A)),
        'a_k_norm': gain((DEPTH, DH_A)),
        'a_lam_q1': nrm((DEPTH, DH_A), 0.1),
        'a_lam_k1': nrm((DEPTH, DH_A), 0.1),
        'a_lam_q2': nrm((DEPTH, DH_A), 0.1),
        'a_lam_k2': nrm((DEPTH, DH_A), 0.1),
        'a_sub_norm': gain((DEPTH, DV_A)),
        'w_branch_a': nrm((DEPTH, A_V, d), A_V ** -0.5),
        'w_branch_b': nrm((DEPTH, B_QKV, d), B_QKV ** -0.5),
        'w_out': nrm((DEPTH, d, d), d ** -0.5),
        'ffn2_norm': gain((DEPTH, d)),
        'ffn2_w_gate': nrm((DEPTH, d, f), d ** -0.5),
        'ffn2_w_up': nrm((DEPTH, d, f), d ** -0.5),
        'ffn2_w_down': nrm((DEPTH, f, d), f ** -0.5),
    }


def reference(x_prompt, x_sample, cache_a_k, cache_a_v, cache_b_k, cache_b_v,
              ffn1_norm, ffn1_w_gate, ffn1_w_up, ffn1_w_down,
              mix_norm, w_in, a_q_norm, a_k_norm,
              a_lam_q1, a_lam_k1, a_lam_q2, a_lam_k2, a_sub_norm,
              w_branch_a, w_branch_b, w_out,
              ffn2_norm, ffn2_w_gate, ffn2_w_up, ffn2_w_down):
    pos_p = jnp.arange(x_prompt.shape[1])
    pos_s = cache_a_k.shape[2] + jnp.arange(x_sample.shape[1])
    yp, ys = x_prompt, x_sample
    rows_p, rows_s = [], []
    for li in range(DEPTH):
        p = {
            'ffn1_norm': ffn1_norm[li], 'ffn1_w_gate': ffn1_w_gate[li],
            'ffn1_w_up': ffn1_w_up[li], 'ffn1_w_down': ffn1_w_down[li],
            'mix_norm': mix_norm[li], 'w_in': w_in[li],
            'a_q_norm': a_q_norm[li], 'a_k_norm': a_k_norm[li],
            'a_lam_q1': a_lam_q1[li], 'a_lam_k1': a_lam_k1[li],
            'a_lam_q2': a_lam_q2[li], 'a_lam_k2': a_lam_k2[li],
            'a_sub_norm': a_sub_norm[li],
            'w_branch_a': w_branch_a[li], 'w_branch_b': w_branch_b[li], 'w_out': w_out[li],
            'ffn2_norm': ffn2_norm[li], 'ffn2_w_gate': ffn2_w_gate[li],
            'ffn2_w_up': ffn2_w_up[li], 'ffn2_w_down': ffn2_w_down[li],
        }
        yp, rp = _layer(yp, pos_p, None, li, p)
        past = (cache_a_k[li], cache_a_v[li], cache_b_k[li], cache_b_v[li])
        ys, rs = _layer(ys, pos_s, past, li, p)
        rows_p.append(rp)
        rows_s.append(rs)
    new_a_k_prompt = jnp.stack([r[0] for r in rows_p], axis=0)
    new_a_v_prompt = jnp.stack([r[1] for r in rows_p], axis=0)
    new_b_k_prompt = jnp.stack([r[2] for r in rows_p], axis=0)
    new_b_v_prompt = jnp.stack([r[3] for r in rows_p], axis=0)
    new_a_k_sample = jnp.stack([r[0] for r in rows_s], axis=0)
    new_a_v_sample = jnp.stack([r[1] for r in rows_s], axis=0)
    new_b_k_sample = jnp.stack([r[2] for r in rows_s], axis=0)
    new_b_v_sample = jnp.stack([r[3] for r in rows_s], axis=0)
    return (yp, ys, new_a_k_prompt, new_a_v_prompt, new_b_k_prompt, new_b_v_prompt,
            new_a_k_sample, new_a_v_sample, new_b_k_sample, new_b_v_sample)
```

```cpp
#include <hip/hip_runtime.h>
#include <cstdio>
#include <cstdint>

#ifndef MK_PER_PHASE
#define MK_PER_PHASE 0
#endif

constexpr int DM = 2048, SEQ = 8192, DEPTH = 2, DECB = 8, DECS = 32, PAST = 1024;
constexpr int MP = SEQ, MS = DECB * DECS, M = MP + MS;
constexpr int DFF = 5632, NIN = 10240, SKV = PAST + DECS;
constexpr int C_QA = 0, C_KA = 1024, C_VA = 2048, C_QB = 3072, C_KB = 4096, C_VB = 5120, C_GA = 6144, C_GB = 8192;
constexpr float EPS = 1e-6f, SM_SCALE = 0.088388347648318440f, LOG2E = 1.4426950408889634f;
constexpr size_t O_Y = 0, O_AKP = (size_t)M * DM, O_AVP = O_AKP + (size_t)2 * MP * 1024, O_BKP = O_AVP + (size_t)2 * MP * 1024, O_BVP = O_BKP + (size_t)2 * MP * 1024,
                 O_AKS = O_BVP + (size_t)2 * MP * 1024, O_AVS = O_AKS + (size_t)2 * MS * 1024, O_BKS = O_AVS + (size_t)2 * MS * 1024, O_BVS = O_BKS + (size_t)2 * MS * 1024,
                 O_END = O_BVS + (size_t)2 * MS * 1024;
static_assert(O_END == 86507520ull, "output size");

constexpr size_t al256(size_t x) { return (x + 255) / 256 * 256; }
constexpr size_t WS_CTL = 0, CTL_BYTES = 1u << 20;
constexpr size_t SZ_WGU = (size_t)2 * DFF * DM * 2, SZ_WD = (size_t)DM * DFF * 2, SZ_WIN = (size_t)NIN * DM * 2, SZ_WBR = (size_t)4096 * 1024 * 2, SZ_WO = (size_t)DM * DM * 2;
constexpr size_t LW_GU1 = 0, LW_D1 = LW_GU1 + SZ_WGU, LW_IN = LW_D1 + SZ_WD, LW_BR = LW_IN + SZ_WIN, LW_O = LW_BR + SZ_WBR, LW_GU2 = LW_O + SZ_WO, LW_D2 = LW_GU2 + SZ_WGU, LW_SZ = LW_D2 + SZ_WD;
constexpr size_t WS_W = CTL_BYTES;
constexpr size_t WS_H = WS_W + 2 * LW_SZ;
constexpr size_t WS_HID = WS_H + (size_t)M * DM * 2;
constexpr size_t WS_T = WS_HID;
constexpr size_t WS_PROJ = WS_HID + (size_t)M * DFF * 2;
constexpr size_t WS_QA = WS_PROJ + (size_t)M * NIN * 2;
constexpr size_t WS_KA = WS_QA + (size_t)M * 1024 * 2;
constexpr size_t WS_VA = WS_KA + (size_t)M * 1024 * 2;
constexpr size_t WS_OS = WS_VA + (size_t)M * 1024 * 2;
constexpr size_t WS_OA = WS_OS + (size_t)M * 2048 * 4;
constexpr size_t WS_OB = WS_OA + (size_t)M * 1024 * 2;
constexpr size_t WS_MRG = WS_OB + (size_t)M * 1024 * 2;
constexpr size_t WS_TAB = WS_MRG + (size_t)M * DM * 2;
constexpr size_t SZ_SKN = (size_t)MS * 1024 * 2;
constexpr size_t WS_SKN = WS_TAB + (size_t)SEQ * 64 * 8;
constexpr size_t WS_PS = WS_SKN + 8 * SZ_SKN;
constexpr size_t WS_XS = WS_PS + (size_t)4 * MS * NIN * 4;
constexpr size_t WS_XB = WS_XS + (size_t)11 * MS * DM * 4;
constexpr size_t WS_END = WS_XB + (size_t)MP * DM * 2;
static_assert((size_t)M * DM * 4 <= (size_t)M * DFF * 2, "T overlays HID");
constexpr int CW_BAR = 4096, CW_ATT = 16384, CW_GUS = 20480;

#define GAS __attribute__((address_space(1)))
#define LAS __attribute__((address_space(3)))
typedef unsigned short bf16;
typedef short bf16x8 __attribute__((ext_vector_type(8)));
typedef float f32x4 __attribute__((ext_vector_type(4)));
typedef float f32x16 __attribute__((ext_vector_type(16)));
typedef unsigned u32x4 __attribute__((ext_vector_type(4)));
typedef unsigned u32x2 __attribute__((ext_vector_type(2)));

__device__ __forceinline__ unsigned f2bf(float f) { unsigned u = __builtin_bit_cast(unsigned, f); return (u + 0x7fffu + ((u >> 16) & 1u)) >> 16; }
__device__ __forceinline__ unsigned pk2(float lo, float hi) { return f2bf(lo) | (f2bf(hi) << 16); }
__device__ __forceinline__ float bf2f(unsigned short b) { return __builtin_bit_cast(float, ((unsigned)b) << 16); }
__device__ __forceinline__ float bflo(unsigned w) { return __builtin_bit_cast(float, w << 16); }
__device__ __forceinline__ float bfhi(unsigned w) { return __builtin_bit_cast(float, w & 0xffff0000u); }
__device__ __forceinline__ unsigned cvt_pk_bf16(float lo, float hi) { unsigned r; asm volatile("v_cvt_pk_bf16_f32 %0, %1, %2" : "=v"(r) : "v"(lo), "v"(hi)); return r; }
template <int X> __device__ __forceinline__ float swz_xor(float v) { return __builtin_bit_cast(float, __builtin_amdgcn_ds_swizzle(__builtin_bit_cast(int, v), 0x1F | (X << 10))); }
__device__ __forceinline__ void half_swap(float v, float& x0, float& x1) { const unsigned a = __float_as_uint(v);
    auto rr = __builtin_amdgcn_permlane32_swap(a, a, false, false); const unsigned r0 = rr[0], r1 = rr[1]; x0 = __uint_as_float(r0); x1 = __uint_as_float(r1); }
__device__ __forceinline__ float xor32_sum(float v) { float x0, x1; half_swap(v, x0, x1); return x0 + x1; }
__device__ __forceinline__ float xor32_max(float v) { float x0, x1; half_swap(v, x0, x1); return fmaxf(x0, x1); }
__device__ __forceinline__ float wave_sum(float v) {
    v += swz_xor<1>(v); v += swz_xor<2>(v); v += swz_xor<4>(v); v += swz_xor<8>(v); v += swz_xor<16>(v);
    return xor32_sum(v);
}
__device__ __forceinline__ float sigmoidf_(float x) { return __builtin_amdgcn_rcpf(1.0f + __expf(-x)); }

__host__ __device__ __forceinline__ int qk_phys(int c) { const int d = c & 127, p = d >> 6, dd = d & 63; return (c & ~127) + 32 * (dd >> 4) + 8 * ((dd >> 2) & 3) + 4 * p + (dd & 3); }

#define XB_TMO      128
#define XB_XCNT(j)  (256  + 64 * (j))
#define XB_XSUB(j)  (1280 + 64 * (j))
#define XB_XGEN(j)  (2304 + 64 * (j))
#define XB_TOP      3328
#define XB_TOPGEN   3392
#define XCD_BAR_WORDS 3456
#define XB_SPIN_CAP (1u << 22)
__device__ __forceinline__ unsigned xb_ld(unsigned* p)              { return __hip_atomic_load(p, __ATOMIC_RELAXED, __HIP_MEMORY_SCOPE_AGENT); }
__device__ __forceinline__ unsigned xb_add(unsigned* p, unsigned v) { return __hip_atomic_fetch_add(p, v, __ATOMIC_RELAXED, __HIP_MEMORY_SCOPE_AGENT); }
__device__ __forceinline__ unsigned xb_xcc_id() { return (unsigned)__builtin_amdgcn_s_getreg((3 << 11) | 20) & 0xFu; }
#define XB_SPIN(cond, bar) do { unsigned _sp = 0; while (cond) { __builtin_amdgcn_s_sleep(1); \
    if ((++_sp & 255u) == 0u) { if (xb_ld(&(bar)[XB_TMO])) break; if (_sp > XB_SPIN_CAP) { atomicAdd(&(bar)[XB_TMO], 1u); break; } } } } while (0)
struct XcdBarrier { unsigned* bar; unsigned x; volatile LAS unsigned* st; };
__device__ __forceinline__ XcdBarrier xcd_barrier_post(unsigned* bar, volatile LAS unsigned* st) {
    XcdBarrier b; b.bar = bar; b.x = xb_xcc_id(); b.st = st;
    if (threadIdx.x == 0) (void)xb_add(&bar[XB_XCNT(b.x)], 1u);
    return b;
}
__device__ __forceinline__ void xcd_barrier_complete(unsigned* bar, unsigned x, unsigned& nloc, unsigned& nx) {
    const unsigned G = gridDim.x * gridDim.y * gridDim.z;
    unsigned sum, cnt, mine, sp = 0u;
    for (;;) {
        sum = 0u; cnt = 0u; mine = 0u;
#pragma unroll
        for (unsigned j = 0; j < 16; ++j) { const unsigned c = xb_ld(&bar[XB_XCNT(j)]); sum += c; cnt += (c > 0u) ? 1u : 0u; mine = (j == x) ? c : mine; }
        if (sum == G) break;
        __builtin_amdgcn_s_sleep(1);
        if ((++sp & 255u) == 0u) { if (xb_ld(&bar[XB_TMO])) break; if (sp > XB_SPIN_CAP) { atomicAdd(&bar[XB_TMO], 1u); break; } }
    }
    nloc = mine > 0u ? mine : 1u; nx = cnt > 0u ? cnt : 1u;
}
__device__ __forceinline__ void xcd_barrier(const XcdBarrier& b) {
    asm volatile("s_waitcnt vmcnt(0)" ::: "memory");
    __syncthreads();
    if (threadIdx.x == 0) {
        unsigned* bar = b.bar;
        __builtin_amdgcn_s_waitcnt(0);
        unsigned nloc = b.st[0], nx = b.st[1];
        if (nloc == 0u) { xcd_barrier_complete(bar, b.x, nloc, nx); b.st[0] = nloc; b.st[1] = nx; }
        const unsigned old = xb_add(&bar[XB_XSUB(b.x)], 1u);
        const unsigned gen = old / nloc;
        if (old + 1u == (gen + 1u) * nloc) {
            __builtin_amdgcn_fence(__ATOMIC_RELEASE, "agent");
            asm volatile("s_waitcnt vmcnt(0)" ::: "memory");
            const unsigned og = xb_add(&bar[XB_TOP], 1u);
            const unsigned tg = og / nx;
            if (og + 1u == (tg + 1u) * nx) xb_add(&bar[XB_TOPGEN], 1u);
            else XB_SPIN(xb_ld(&bar[XB_TOPGEN]) == tg, bar);
            __builtin_amdgcn_fence(__ATOMIC_ACQUIRE, "agent");
            xb_add(&bar[XB_XGEN(b.x)], 1u);
            asm volatile("s_waitcnt vmcnt(0)" ::: "memory");
        } else {
            XB_SPIN(xb_ld(&bar[XB_XGEN(b.x)]) == gen, bar);
            __builtin_amdgcn_fence(__ATOMIC_ACQUIRE, "agent");
            asm volatile("s_waitcnt vmcnt(0)" ::: "memory");
        }
    }
    __syncthreads();
}

namespace pg8 {
constexpr int BM = 256, BK = 64, HALF = 128, HTB = HALF * BK * 2, STAGE_BYTES = 8 * HTB, NXCD = 8, WGM = 8;
__host__ __device__ __forceinline__ int lds_byte(int r, int c) { const int st = (r >> 4) * 2 + (c >> 5), rr = r & 15, cc = c & 31, ob = rr * 64 + cc * 2; return st * 1024 + (ob ^ (((ob >> 9) & 1) << 5)); }
__host__ __device__ __forceinline__ void stage_rc(int b, int& R, int& C) { const int st = b / 1024, sb = b % 1024, swz = sb ^ (((sb >> 9) & 1) << 5); R = (st >> 1) * 16 + swz / 64; C = (st & 1) * 32 + (swz % 64) / 2; }
__host__ __device__ __forceinline__ int perm32(int rho) { const int n = rho >> 4, i = rho & 15; return 8 * (i >> 2) + 4 * n + (i & 3); }
struct Unit { int pm, pn, k0, nk, kind; };
struct Gemm { const bf16* A; const bf16* Bt; int ld; };
__device__ __forceinline__ void tile_of(int L, int nM, int nN, int& pm, int& pn) {
    const int nwg = nM * nN; int wgid = L; { const int q = nwg / NXCD, r = nwg % NXCD, xcd = wgid % NXCD, off = wgid / NXCD; wgid = (xcd < r ? xcd * (q + 1) : r * (q + 1) + (xcd - r) * q) + off; }
    const int nig = WGM * nN, gid = wgid / nig, fm = gid * WGM, gsz = (nM - fm) < WGM ? (nM - fm) : WGM;
    pm = fm + ((wgid % nig) % gsz); pn = (wgid % nig) / gsz;
}
__device__ __forceinline__ int perm40(int pn) { const int p = pn >= 20, q = pn - 20 * p, i = q >> 2, a = q & 3;
    const unsigned t = p ? (4u | 20u << 6 | 28u << 12 | 32u << 18 | 36u << 24) : (0u | 8u << 6 | 16u << 12 | 12u << 18 | 24u << 24); return (int)((t >> (6 * i)) & 63u) + a; }
struct PanelOrder {
    int nN, nP, G, c, K, sSplit, sNk;
    __device__ __forceinline__ void init(int N_, int K_, int G_, int c_, int sSplit_) { nN = N_ / BM; nP = 32 * nN; G = G_; c = c_; K = K_; sSplit = sSplit_; sNk = sSplit_ > 0 ? K_ / sSplit_ : 0; }
    __device__ __forceinline__ bool next(int i, Unit& u) const {
        const int L = i * G + c;
        if (L < nP) { tile_of(L, 32, nN, u.pm, u.pn); if (nN == 40) u.pn = perm40(u.pn); u.k0 = 0; u.nk = K; u.kind = 0; return true; }
        const int j = L - nP; if (j >= nN * sSplit) return false;
        u.pm = 32; u.pn = j / sSplit; u.k0 = (j % sSplit) * sNk; u.nk = sNk; u.kind = sSplit > 1 ? 1 : 0; return true;
    }
    __device__ __forceinline__ void a_ready(const Unit&) const {}
    __device__ __forceinline__ void done(const Unit&) const {}
};
struct GuOrder {
    int G, c; unsigned* flag;
    __device__ __forceinline__ bool next(int i, Unit& u) const {
        const int L = i * G + c; u.k0 = 0; u.nk = DM; u.kind = 0;
        if (L < 44) { u.pm = 32; u.pn = L; return true; }
        const int Lp = L < 48 ? 1404 + (L - 44) : L - 48; if (L >= 48 && Lp >= 1404) return false;
        tile_of(Lp, 32, 44, u.pm, u.pn); return true;
    }
    __device__ __forceinline__ void a_ready(const Unit&) const {}
    __device__ __forceinline__ void done(const Unit& u) const {
        if (u.pm == 32) { asm volatile("s_waitcnt vmcnt(0)" ::: "memory"); __builtin_amdgcn_s_barrier();
            if (threadIdx.x == 0) { __builtin_amdgcn_fence(__ATOMIC_RELEASE, "agent"); asm volatile("s_waitcnt vmcnt(0)" ::: "memory"); (void)xb_add(flag, 1u); } }
    }
};
struct SampleDownOrder {
    int nI, ci;
    __device__ __forceinline__ bool next(int i, Unit& u) const {
        const int j = i * nI + ci; if (j >= 32) return false;
        u.pm = 32; u.pn = j >> 2; u.k0 = (j & 3) * 1408; u.nk = 1408; u.kind = 1; return true;
    }
    __device__ __forceinline__ void a_ready(const Unit&) const {}
    __device__ __forceinline__ void done(const Unit&) const {}
};
struct BranchOrder {
    int G, c;
    __device__ __forceinline__ bool next(int i, Unit& u) const {
        const int tI = (i >> 1) * G + c, which = i & 1; if (tI >= 256) return false;
        int pm, pn; tile_of(tI, 32, 8, pm, pn);
        u.pm = pm + 33 * which; u.pn = pn + 8 * which; u.k0 = 0; u.nk = 1024; u.kind = which; return true;
    }
    __device__ __forceinline__ void a_ready(const Unit&) const {}
    __device__ __forceinline__ void done(const Unit&) const {}
};
struct SampleBranchOrder {
    int G, c;
    __device__ __forceinline__ bool next(int i, Unit& u) const {
        const int j = i * G + c; if (j >= 32) return false;
        const int tile = j >> 2, which = (j >> 1) & 1, kh = j & 1;
        u.pm = 32 + 33 * which; u.pn = tile + 8 * which; u.k0 = kh * 512; u.nk = 512; u.kind = 2 * which + kh; return true;
    }
    __device__ __forceinline__ void a_ready(const Unit&) const {}
    __device__ __forceinline__ void done(const Unit&) const {}
};
template <class Epi, class Sched, bool ALIGN_EPI = true, bool SP2 = true>
__device__ __forceinline__ void gemm_phase(LAS unsigned char* lds, const Gemm g, const Sched& S, const Epi& E) {
    int tid_ = threadIdx.x; asm volatile("" : "+v"(tid_));
    const int tid = tid_, wid = __builtin_amdgcn_readfirstlane(tid >> 6), lane = tid & 63, wr = wid >> 2, wc = wid & 3, fr = lane & 15, fq = lane >> 4;
    const int K = g.ld;
    unsigned voffA[2], voffB[2];
#pragma unroll
    for (int i = 0; i < 2; ++i) { int R, C; stage_rc(tid * 16 + i * 8192, R, C); const int Rb = Epi::PERM ? ((R & ~31) + perm32(R & 31)) : R;
        voffA[i] = (unsigned)(R * K + C) * 2u; voffB[i] = (unsigned)(Rb * K + C) * 2u; }
    const size_t kstep = (size_t)(BK * 2);
    const size_t hstep = (size_t)HALF * K * 2;
    const size_t tstep = 2 * hstep;
    const unsigned ldsw = (unsigned)wid * 1024u;
    const int aoff = lds_byte(wr * 64 + fr, fq * 8), boff = lds_byte(wc * 32 + fr, fq * 8);
#define PG8_SA(b, h) (((b) * 2 + (h)) * HTB)
#define PG8_SB(b, h) ((4 + (b) * 2 + (h)) * HTB)
#define PG8_STAGE(bufoff, gbase, voff) do { _Pragma("unroll") for (int _i = 0; _i < 2; ++_i) \
        __builtin_amdgcn_global_load_lds((const unsigned*)((const char*)(gbase) + (voff)[_i]), (LAS unsigned*)(lds + (bufoff) + ldsw + _i * 8192), 16, 0, 0); } while (0)
#define PG8_LDA(dst, b, h) do { _Pragma("unroll") for (int m = 0; m < 4; ++m) _Pragma("unroll") for (int k = 0; k < 2; ++k) dst[m][k] = *(const LAS bf16x8*)(lds + PG8_SA(b, h) + aoff + m * 2048 + k * 1024); } while (0)
#define PG8_LDB(dst, b, h) do { _Pragma("unroll") for (int n = 0; n < 2; ++n) _Pragma("unroll") for (int k = 0; k < 2; ++k) dst[n][k] = *(const LAS bf16x8*)(lds + PG8_SB(b, h) + boff + n * 2048 + k * 1024); } while (0)
#define PG8_MMA(ai, bj, At, Bt) do { __builtin_amdgcn_s_setprio(1); _Pragma("unroll") for (int m = 0; m < 4; ++m) _Pragma("unroll") for (int n = 0; n < 2; ++n) _Pragma("unroll") for (int k = 0; k < 2; ++k) \
        acc[ai][bj][m][n] = __builtin_amdgcn_mfma_f32_16x16x32_bf16(Bt[n][k], At[m][k], acc[ai][bj][m][n], 0, 0, 0); __builtin_amdgcn_s_setprio(0); } while (0)
#define PG8_WAIT_V(n) asm volatile("s_waitcnt vmcnt(" #n ")" ::: "memory")
#define PG8_WAIT_L(n) asm volatile("s_waitcnt lgkmcnt(" #n ")" ::: "memory")
#define PG8_BAR __builtin_amdgcn_s_barrier()
#define PG8_SCHED __builtin_amdgcn_sched_barrier(0)
    Unit cur, nxt; int ui = 0;
    if (!S.next(0, cur)) return;
    f32x4 acc[2][2][4][2];
#pragma unroll
    for (int a = 0; a < 2; ++a)
#pragma unroll
        for (int b = 0; b < 2; ++b)
#pragma unroll
            for (int m = 0; m < 4; ++m)
#pragma unroll
                for (int n = 0; n < 2; ++n) acc[a][b][m][n] = (f32x4){0.f, 0.f, 0.f, 0.f};
    bf16x8 At[4][2], B0[2][2], B1[2][2];
    const char* cA = (const char*)g.A + (size_t)cur.pm * tstep + (size_t)cur.k0 * 2; const char* cB = (const char*)g.Bt + (size_t)cur.pn * tstep + (size_t)cur.k0 * 2;
    S.a_ready(cur);
    PG8_STAGE(PG8_SB(0, 0), cB, voffB); PG8_STAGE(PG8_SB(0, 1), cB + hstep, voffB); PG8_STAGE(PG8_SA(0, 0), cA, voffA); PG8_STAGE(PG8_SA(0, 1), cA + hstep, voffA);
    if (wr == 1) PG8_BAR;
    PG8_WAIT_V(2); PG8_BAR;
    PG8_STAGE(PG8_SB(1, 0), cB + kstep, voffB); PG8_STAGE(PG8_SA(1, 0), cA + kstep, voffA); PG8_STAGE(PG8_SB(1, 1), cB + hstep + kstep, voffB);
    PG8_WAIT_V(6); PG8_BAR;
    bool has_next; const char* nA; const char* nB;
#define PG8_NEXT() do { has_next = S.next(ui + 1, nxt); \
        nA = has_next ? (const char*)g.A + (size_t)nxt.pm * tstep + (size_t)nxt.k0 * 2 : cA; nB = has_next ? (const char*)g.Bt + (size_t)nxt.pn * tstep + (size_t)nxt.k0 * 2 : cB; } while (0)
#define PG8_KLOOP() do { const int nt = cur.nk / BK; \
        for (int t = 0; t < nt; t += 2) { \
            const bool last = (t == nt - 2); \
            const char* a1 = cA + (size_t)(t + 1) * kstep; \
            const char* a2 = last ? nA : cA + (size_t)(t + 2) * kstep; const char* b2 = last ? nB : cB + (size_t)(t + 2) * kstep; \
            const char* a3 = a2 + kstep; const char* b3 = b2 + kstep; \
            if (last && has_next) S.a_ready(nxt); \
            PG8_LDB(B0, 0, 0); PG8_LDB(B1, 0, 1); PG8_SCHED; PG8_LDA(At, 0, 0); PG8_STAGE(PG8_SA(1, 1), a1 + hstep, voffA); \
            PG8_WAIT_V(8); PG8_WAIT_L(0); PG8_BAR; PG8_MMA(0, 0, At, B0); PG8_MMA(0, 1, At, B1); PG8_BAR; PG8_SCHED; \
            PG8_LDA(At, 0, 1); PG8_STAGE(PG8_SB(0, 0), b2, voffB); PG8_STAGE(PG8_SB(0, 1), b2 + hstep, voffB); PG8_STAGE(PG8_SA(0, 0), a2, voffA); \
            PG8_WAIT_V(8); PG8_WAIT_L(0); PG8_BAR; PG8_MMA(1, 0, At, B0); PG8_MMA(1, 1, At, B1); PG8_BAR; PG8_SCHED; \
            PG8_LDB(B0, 1, 0); PG8_LDB(B1, 1, 1); PG8_SCHED; PG8_LDA(At, 1, 0); PG8_STAGE(PG8_SA(0, 1), a2 + hstep, voffA); \
            PG8_WAIT_V(8); PG8_WAIT_L(0); PG8_BAR; PG8_MMA(0, 0, At, B0); PG8_MMA(0, 1, At, B1); PG8_BAR; PG8_SCHED; \
            PG8_LDA(At, 1, 1); PG8_STAGE(PG8_SB(1, 0), b3, voffB); PG8_STAGE(PG8_SB(1, 1), b3 + hstep, voffB); PG8_STAGE(PG8_SA(1, 0), a3, voffA); \
            PG8_WAIT_V(8); PG8_WAIT_L(0); PG8_BAR; PG8_MMA(1, 0, At, B0); PG8_MMA(1, 1, At, B1); PG8_BAR; PG8_SCHED; \
        } } while (0)
    static_assert(SP2, "only the two-super-phase K-loop is kept");
    for (;;) {
        PG8_NEXT();
        PG8_KLOOP();
        if constexpr (Epi::PAIRED) {
            E.mid(acc, cur, wr, wc, fr, fq);
            cur = nxt; cA = nA; cB = nB; ++ui;
            PG8_NEXT();
            PG8_KLOOP();
        }
        if constexpr (ALIGN_EPI) { if (wr == 0) PG8_BAR; }
        E(acc, cur, wr, wc, fr, fq); S.done(cur);
        if (!has_next) break;
#pragma unroll
        for (int a = 0; a < 2; ++a)
#pragma unroll
            for (int b = 0; b < 2; ++b)
#pragma unroll
                for (int m = 0; m < 4; ++m)
#pragma unroll
                    for (int n = 0; n < 2; ++n) acc[a][b][m][n] = (f32x4){0.f, 0.f, 0.f, 0.f};
        cur = nxt; cA = nA; cB = nB; ++ui;
        if constexpr (ALIGN_EPI) { if (wr == 1) PG8_BAR; }
    }
    PG8_WAIT_V(0);
    if constexpr (!ALIGN_EPI) { if (wr == 0) PG8_BAR; }
    PG8_BAR;
#undef PG8_NEXT
#undef PG8_KLOOP
#undef PG8_SA
#undef PG8_SB
#undef PG8_STAGE
#undef PG8_LDA
#undef PG8_LDB
#undef PG8_MMA
#undef PG8_WAIT_V
#undef PG8_WAIT_L
#undef PG8_BAR
#undef PG8_SCHED
}

constexpr int XCH_OFF = 135168;
struct EpiProj {
    static constexpr bool PERM = true, PAIRED = false;
    bf16* O; float* PS; bf16* QA; bf16* KA; bf16* VA; float* out; const float* gq; const float* gk; const float2* tab; int l; LAS unsigned char* lds;
    __device__ __forceinline__ void operator()(const f32x4 (&acc)[2][2][4][2], const Unit& u, int wr, int wc, int fr_, int fq_) const {
        int fr = fr_, fq = fq_; asm volatile("" : "+v"(fr), "+v"(fq));
        const int col0 = u.pn * BM + wc * 32 + 8 * fq;
        if (u.kind != 0) { const int row0 = wr * 64 + fr; float* slab = PS + (size_t)(u.k0 / u.nk) * MS * NIN;
#pragma unroll
            for (int ai = 0; ai < 2; ++ai)
#pragma unroll
                for (int m = 0; m < 4; ++m) { float* rowp = slab + (size_t)(row0 + ai * HALF + m * 16) * NIN + col0;
#pragma unroll
                    for (int bj = 0; bj < 2; ++bj) { *(f32x4*)(rowp + bj * HALF) = acc[ai][bj][m][0]; *(f32x4*)(rowp + bj * HALF + 4) = acc[ai][bj][m][1]; } }
            return; }
        const int row0 = u.pm * BM + wr * 64 + fr;
        if (u.pn < 8) {
            const bool isk = u.pn >= 4; const float* gg = isk ? gk : gq; const int dd0 = 16 * wc + 4 * fq;
            const f32x4 g1 = *(const f32x4*)(gg + dd0), g2 = *(const f32x4*)(gg + 64 + dd0);
            LAS float* xch = (LAS float*)(lds + XCH_OFF);
            f32x4 cst[2][4][2];
#pragma unroll
            for (int ai = 0; ai < 2; ++ai)
#pragma unroll
                for (int m = 0; m < 4; ++m) { const size_t row = (size_t)(row0 + ai * HALF + m * 16); cst[ai][m][0] = *(const f32x4*)(tab + row * 64 + dd0); cst[ai][m][1] = *(const f32x4*)(tab + row * 64 + dd0 + 2); }
#pragma unroll
            for (int ai = 0; ai < 2; ++ai)
#pragma unroll
                for (int m = 0; m < 4; ++m) { const int rl = ai * HALF + wr * 64 + m * 16 + fr;
#pragma unroll
                    for (int bj = 0; bj < 2; ++bj) { const f32x4 a = acc[ai][bj][m][0], b = acc[ai][bj][m][1];
                        float s = (a[0] * a[0] + a[1] * a[1]) + (a[2] * a[2] + a[3] * a[3]) + (b[0] * b[0] + b[1] * b[1]) + (b[2] * b[2] + b[3] * b[3]);
                        s += swz_xor<16>(s); s = xor32_sum(s);
                        if (fq == 0) xch[(rl * 2 + bj) * 4 + wc] = s; } }
            asm volatile("s_waitcnt lgkmcnt(0)" ::: "memory"); __builtin_amdgcn_s_barrier(); asm volatile("" ::: "memory");
            bf16* dq = isk ? KA : QA; float* oak = out + O_AKP + (size_t)l * MP * 1024;
#pragma unroll
            for (int ai = 0; ai < 2; ++ai)
#pragma unroll
                for (int m = 0; m < 4; ++m) { const int rl = ai * HALF + wr * 64 + m * 16 + fr; const size_t row = (size_t)(row0 + ai * HALF + m * 16);
                    const f32x4 c01 = cst[ai][m][0], c23 = cst[ai][m][1];
                    const float cs[4] = {c01[0], c01[2], c23[0], c23[2]}, sn[4] = {c01[1], c01[3], c23[1], c23[3]};
#pragma unroll
                    for (int bj = 0; bj < 2; ++bj) { const f32x4 t = *(const LAS f32x4*)(xch + (rl * 2 + bj) * 4);
                        const float r = 1.0f / sqrtf(((t[0] + t[1]) + (t[2] + t[3])) * (1.0f / 128) + EPS);
                        f32x4 o1, o2;
#pragma unroll
                        for (int e = 0; e < 4; ++e) { const float y1 = acc[ai][bj][m][0][e] * r * g1[e], y2 = acc[ai][bj][m][1][e] * r * g2[e]; o1[e] = y1 * cs[e] - y2 * sn[e]; o2[e] = y2 * cs[e] + y1 * sn[e]; }
                        const int hc = (2 * (u.pn & 3) + bj) * 128 + dd0;
                        u32x2 w; w.x = cvt_pk_bf16(o1[0], o1[1]); w.y = cvt_pk_bf16(o1[2], o1[3]); *(u32x2*)(dq + row * 1024 + hc) = w;
                        w.x = cvt_pk_bf16(o2[0], o2[1]); w.y = cvt_pk_bf16(o2[2], o2[3]); *(u32x2*)(dq + row * 1024 + hc + 64) = w;
                        if (isk) { *(f32x4*)(oak + row * 1024 + hc) = o1; *(f32x4*)(oak + row * 1024 + hc + 64) = o2; } } }
        } else {
            const int t4 = u.pn >> 2;
            float* fo = (t4 == 2) ? out + O_AVP + (size_t)l * MP * 1024 - C_VA : (t4 == 4) ? out + O_BKP + (size_t)l * MP * 1024 - C_KB : (t4 == 5) ? out + O_BVP + (size_t)l * MP * 1024 - C_VB : nullptr;
#pragma unroll
            for (int ai = 0; ai < 2; ++ai)
#pragma unroll
                for (int m = 0; m < 4; ++m) { const size_t row = (size_t)(row0 + ai * HALF + m * 16); bf16* rowp = (t4 == 2) ? VA + row * 1024 + (col0 - C_VA) : O + row * NIN + col0;
#pragma unroll
                    for (int bj = 0; bj < 2; ++bj) { const f32x4 v0 = acc[ai][bj][m][0], v1 = acc[ai][bj][m][1];
                        u32x4 w; w.x = cvt_pk_bf16(v0[0], v0[1]); w.y = cvt_pk_bf16(v0[2], v0[3]); w.z = cvt_pk_bf16(v1[0], v1[1]); w.w = cvt_pk_bf16(v1[2], v1[3]);
                        *(u32x4*)(rowp + bj * HALF) = w;
                        if (fo) { float* fp = fo + row * 1024 + col0 + bj * HALF; *(f32x4*)fp = v0; *(f32x4*)(fp + 4) = v1; } } }
        }
    }
};
struct EpiSwiGLU {
    static constexpr bool PERM = true, PAIRED = false;
    bf16* O; int ldc;
    __device__ __forceinline__ void operator()(const f32x4 (&acc)[2][2][4][2], const Unit& u, int wr, int wc, int fr_, int fq_) const {
        int fr = fr_, fq = fq_; asm volatile("" : "+v"(fr), "+v"(fq));
        const int row0 = u.pm * BM + wr * 64 + fr, col0 = u.pn * HALF + wc * 32 + 8 * fq;
#pragma unroll
        for (int ai = 0; ai < 2; ++ai)
#pragma unroll
            for (int m = 0; m < 4; ++m) { bf16* rowp = O + (size_t)(row0 + ai * HALF + m * 16) * ldc + col0;
                float r[8];
#pragma unroll
                for (int n = 0; n < 2; ++n) { const f32x4 G = acc[ai][0][m][n], U = acc[ai][1][m][n]; f32x4 E, R;
#pragma unroll
                    for (int e = 0; e < 4; ++e) E[e] = __builtin_amdgcn_exp2f(-G[e]);
                    const f32x4 D = E + 1.0f;
#pragma unroll
                    for (int e = 0; e < 4; ++e) R[e] = __builtin_amdgcn_rcpf(D[e]);
                    const f32x4 O = (G * U) * R;
#pragma unroll
                    for (int e = 0; e < 4; ++e) r[n * 4 + e] = O[e]; }
                u32x4 w; w.x = cvt_pk_bf16(r[0], r[1]); w.y = cvt_pk_bf16(r[2], r[3]); w.z = cvt_pk_bf16(r[4], r[5]); w.w = cvt_pk_bf16(r[6], r[7]);
                *(u32x4*)rowp = w; }
    }
};
struct EpiResAdd {
    static constexpr bool PERM = true, PAIRED = false;
    float f; float* XS; const float* Xin; float* Xout; bf16* XB;
    __device__ __forceinline__ void operator()(const f32x4 (&acc)[2][2][4][2], const Unit& u, int wr, int wc, int fr_, int fq_) const {
        int fr = fr_, fq = fq_; asm volatile("" : "+v"(fr), "+v"(fq));
        const int row0 = u.pm * BM + wr * 64 + fr, col0 = u.pn * BM + wc * 32 + 8 * fq;
        if (u.kind == 0) {
#pragma unroll
            for (int ai = 0; ai < 2; ++ai) {
                f32x4 xv[4][2][2];
                if (Xin) {
#pragma unroll
                    for (int m = 0; m < 4; ++m)
#pragma unroll
                        for (int bj = 0; bj < 2; ++bj) { const float* p = Xin + (size_t)(row0 + ai * HALF + m * 16) * DM + col0 + bj * HALF; xv[m][bj][0] = *(const f32x4*)p; xv[m][bj][1] = *(const f32x4*)(p + 4); }
                } else {
#pragma unroll
                    for (int m = 0; m < 4; ++m)
#pragma unroll
                        for (int bj = 0; bj < 2; ++bj) { const u32x4 w = *(const u32x4*)(XB + (size_t)(row0 + ai * HALF + m * 16) * DM + col0 + bj * HALF);
                            xv[m][bj][0] = (f32x4){bflo(w.x), bfhi(w.x), bflo(w.y), bfhi(w.y)}; xv[m][bj][1] = (f32x4){bflo(w.z), bfhi(w.z), bflo(w.w), bfhi(w.w)}; }
                }
#pragma unroll
                for (int m = 0; m < 4; ++m) { const size_t ro = (size_t)(row0 + ai * HALF + m * 16) * DM + col0;
#pragma unroll
                    for (int bj = 0; bj < 2; ++bj) { const f32x4 v0 = xv[m][bj][0] + acc[ai][bj][m][0] * f, v1 = xv[m][bj][1] + acc[ai][bj][m][1] * f;
                        if (Xout) { *(f32x4*)(Xout + ro + bj * HALF) = v0; *(f32x4*)(Xout + ro + bj * HALF + 4) = v1; }
                        else { u32x4 w; w.x = cvt_pk_bf16(v0[0], v0[1]); w.y = cvt_pk_bf16(v0[2], v0[3]); w.z = cvt_pk_bf16(v1[0], v1[1]); w.w = cvt_pk_bf16(v1[2], v1[3]); *(u32x4*)(XB + ro + bj * HALF) = w; } } }
                asm volatile("" ::: "memory"); }
        } else { float* slab = XS + (size_t)(u.k0 / u.nk) * MS * DM;
#pragma unroll
            for (int ai = 0; ai < 2; ++ai)
#pragma unroll
                for (int m = 0; m < 4; ++m) { float* rowp = slab + (size_t)(wr * 64 + fr + ai * HALF + m * 16) * DM + col0;
#pragma unroll
                    for (int bj = 0; bj < 2; ++bj) { *(f32x4*)(rowp + bj * HALF) = acc[ai][bj][m][0] * f; *(f32x4*)(rowp + bj * HALF + 4) = acc[ai][bj][m][1] * f; } }
        }
    }
};
struct EpiBranch {
    static constexpr bool PERM = true, PAIRED = true;
    const bf16* G; bf16* O;
    __device__ __forceinline__ void mid(f32x4 (&acc)[2][2][4][2], const Unit& u, int wr, int wc, int fr_, int fq_) const {
        int fr = fr_, fq = fq_; asm volatile("" : "+v"(fr), "+v"(fq));
        const int row0 = u.pm * BM + wr * 64 + fr, col0 = u.pn * BM + wc * 32 + 8 * fq;
#pragma unroll
        for (int ai = 0; ai < 2; ++ai) {
            u32x4 gav[4][2], gbv[4][2];
#pragma unroll
            for (int m = 0; m < 4; ++m)
#pragma unroll
                for (int bj = 0; bj < 2; ++bj) { const size_t ro = (size_t)(row0 + ai * HALF + m * 16) * NIN + col0 + bj * HALF; gav[m][bj] = *(const u32x4*)(G + ro + C_GA); gbv[m][bj] = *(const u32x4*)(G + ro + C_GB); }
#pragma unroll
            for (int m = 0; m < 4; ++m)
#pragma unroll
                for (int bj = 0; bj < 2; ++bj) { const unsigned gaw[4] = {gav[m][bj].x, gav[m][bj].y, gav[m][bj].z, gav[m][bj].w}, gbw[4] = {gbv[m][bj].x, gbv[m][bj].y, gbv[m][bj].z, gbv[m][bj].w};
#pragma unroll
                    for (int q = 0; q < 4; ++q) { const float a0 = bflo(gaw[q]), a1 = bfhi(gaw[q]), b0 = fmaxf(bflo(gbw[q]), -30.f), b1 = fmaxf(bfhi(gbw[q]), -30.f);
                        const float r0 = (1.0f + __expf(-b0)) * __builtin_amdgcn_rcpf(1.0f + __expf(-a0)), r1 = (1.0f + __expf(-b1)) * __builtin_amdgcn_rcpf(1.0f + __expf(-a1));
                        acc[ai][bj][m][q >> 1][(q & 1) * 2] *= r0; acc[ai][bj][m][q >> 1][(q & 1) * 2 + 1] *= r1; } }
#pragma unroll
            for (int m = 0; m < 4; ++m) asm volatile("" : "+v"(acc[ai][0][m][0]), "+v"(acc[ai][0][m][1]), "+v"(acc[ai][1][m][0]), "+v"(acc[ai][1][m][1]));
            asm volatile("" ::: "memory"); }
    }
    __device__ __forceinline__ void operator()(const f32x4 (&acc)[2][2][4][2], const Unit& u, int wr, int wc, int fr_, int fq_) const {
        int fr = fr_, fq = fq_; asm volatile("" : "+v"(fr), "+v"(fq));
        const int row0 = (u.pm - 33) * BM + wr * 64 + fr, col0 = (u.pn - 8) * BM + wc * 32 + 8 * fq;
#pragma unroll
        for (int ai = 0; ai < 2; ++ai) {
            u32x4 gbv[4][2];
#pragma unroll
            for (int m = 0; m < 4; ++m)
#pragma unroll
                for (int bj = 0; bj < 2; ++bj) gbv[m][bj] = *(const u32x4*)(G + (size_t)(row0 + ai * HALF + m * 16) * NIN + C_GB + col0 + bj * HALF);
#pragma unroll
            for (int m = 0; m < 4; ++m) { const size_t row = (size_t)(row0 + ai * HALF + m * 16);
#pragma unroll
                for (int bj = 0; bj < 2; ++bj) { const int c = col0 + bj * HALF; const unsigned gbw[4] = {gbv[m][bj].x, gbv[m][bj].y, gbv[m][bj].z, gbv[m][bj].w}; float r[8];
#pragma unroll
                    for (int q = 0; q < 4; ++q) { r[2 * q] = acc[ai][bj][m][q >> 1][(q & 1) * 2] * sigmoidf_(fmaxf(bflo(gbw[q]), -30.f)); r[2 * q + 1] = acc[ai][bj][m][q >> 1][(q & 1) * 2 + 1] * sigmoidf_(fmaxf(bfhi(gbw[q]), -30.f)); }
                    u32x4 w; w.x = cvt_pk_bf16(r[0], r[1]); w.y = cvt_pk_bf16(r[2], r[3]); w.z = cvt_pk_bf16(r[4], r[5]); w.w = cvt_pk_bf16(r[6], r[7]);
                    *(u32x4*)(O + row * DM + c) = w; } }
            asm volatile("" ::: "memory"); }
    }
};
struct EpiGateSlab {
    static constexpr bool PERM = true, PAIRED = false;
    const bf16* G; float* SL;
    __device__ __forceinline__ void operator()(const f32x4 (&acc)[2][2][4][2], const Unit& u, int wr, int wc, int fr_, int fq_) const {
        int fr = fr_, fq = fq_; asm volatile("" : "+v"(fr), "+v"(fq));
        const int which = u.kind >> 1, row0 = wr * 64 + fr, col0 = (u.pn - 8 * which) * BM + wc * 32 + 8 * fq, gc = which ? C_GB : C_GA;
        float* slab = SL + (size_t)u.kind * MS * DM;
#pragma unroll
        for (int ai = 0; ai < 2; ++ai) {
            u32x4 gv[4][2];
#pragma unroll
            for (int m = 0; m < 4; ++m)
#pragma unroll
                for (int bj = 0; bj < 2; ++bj) gv[m][bj] = *(const u32x4*)(G + (size_t)(MP + row0 + ai * HALF + m * 16) * NIN + gc + col0 + bj * HALF);
#pragma unroll
            for (int m = 0; m < 4; ++m) { float* rowp = slab + (size_t)(row0 + ai * HALF + m * 16) * DM + col0;
#pragma unroll
                for (int bj = 0; bj < 2; ++bj) { const unsigned gw[4] = {gv[m][bj].x, gv[m][bj].y, gv[m][bj].z, gv[m][bj].w}; f32x4 o0, o1;
                    o0[0] = acc[ai][bj][m][0][0] * sigmoidf_(bflo(gw[0])); o0[1] = acc[ai][bj][m][0][1] * sigmoidf_(bfhi(gw[0])); o0[2] = acc[ai][bj][m][0][2] * sigmoidf_(bflo(gw[1])); o0[3] = acc[ai][bj][m][0][3] * sigmoidf_(bfhi(gw[1]));
                    o1[0] = acc[ai][bj][m][1][0] * sigmoidf_(bflo(gw[2])); o1[1] = acc[ai][bj][m][1][1] * sigmoidf_(bfhi(gw[2])); o1[2] = acc[ai][bj][m][1][2] * sigmoidf_(bflo(gw[3])); o1[3] = acc[ai][bj][m][1][3] * sigmoidf_(bfhi(gw[3]));
                    *(f32x4*)(rowp + bj * HALF) = o0; *(f32x4*)(rowp + bj * HALF + 4) = o1; } }
            asm volatile("" ::: "memory"); }
    }
};
}

constexpr int NWAVES = 8;
constexpr int RING_BYTES = 131072, MISC_OFF = RING_BYTES + 320, LDS_BYTES = 147456;
struct Args { const float* in[26]; float* out; unsigned char* ws; int ph_lo, ph_hi; };
struct Frame {
    LAS unsigned char* lds; int tid, lane, wave, G, gw, NGW;
    float* out; unsigned char* ws;
};
#define FIN(i) (args.in[i])
#define OPAQUE_FRAME(F) Frame F = F0; { int t_ = threadIdx.x; asm volatile("" : "+v"(t_)); F.tid = t_; F.lane = t_ & 63; { size_t z_ = 0; asm volatile("" : "+s"(z_), "+s"(F.gw)); F.ws = F0.ws + z_; F.out = F0.out + z_; } }

__device__ __forceinline__ void transpose_item(const float* W, int K, int N, bf16* WT, int mode, int row_off, LAS float* scr, int item, int lane) {
    const int nblk = N / 32, kb = item / nblk, nb = item % nblk, k0 = 64 * kb, n0 = 32 * nb;
    const float wsc = (mode == 1) ? LOG2E : (mode == 2) ? 0.6931471805599453f : 1.0f;
#pragma unroll 8
    for (int i = 0; i < 32; ++i) { const int kk = 2 * i + (lane >> 5); scr[kk * 33 + (lane & 31)] = W[(size_t)(k0 + kk) * N + n0 + (lane & 31)]; }
    asm volatile("s_waitcnt lgkmcnt(0)" ::: "memory");
    const int rb = (mode == 0 || mode == 3) ? (row_off + n0) : (256 * (n0 >> 7) + (n0 & 127) + (mode == 2 ? 128 : 0));
    const int c = lane & 7;
#pragma unroll
    for (int j = 0; j < 4; ++j) { const int n = (lane >> 3) + 8 * j; const LAS float* s = scr + (8 * c) * 33 + n;
        u32x4 o; o.x = pk2(s[0 * 33] * wsc, s[1 * 33] * wsc); o.y = pk2(s[2 * 33] * wsc, s[3 * 33] * wsc); o.z = pk2(s[4 * 33] * wsc, s[5 * 33] * wsc); o.w = pk2(s[6 * 33] * wsc, s[7 * 33] * wsc);
        const int drow = (mode == 3 && rb < 2048) ? qk_phys(rb + n) : rb + n;
        *(u32x4*)(WT + (size_t)drow * K + k0 + 8 * c) = o; }
    asm volatile("s_waitcnt lgkmcnt(0)" ::: "memory");
}
__device__ __forceinline__ void transpose_matrix(Frame& F, const float* W, int K, int N, bf16* WT, int mode, int row_off) {
    LAS float* scr = (LAS float*)(F.lds + F.wave * 16384);
    const int nitems = (K / 64) * (N / 32);
    for (int it = F.gw; it < nitems; it += F.NGW) transpose_item(W, K, N, WT, mode, row_off, scr, it, F.lane);
}
__device__ __forceinline__ bf16* lw(Frame& F, int l, size_t off) { return (bf16*)(F.ws + WS_W + (size_t)l * LW_SZ + off); }
__device__ __forceinline__ bf16* skn(Frame& F, int l, int t) { return (bf16*)(F.ws + WS_SKN + (size_t)(l * 4 + t) * SZ_SKN); }

__device__ __forceinline__ void phase_prologue(const Frame& F0, const Args& args) {
    OPAQUE_FRAME(F);
    for (int l = 0; l < DEPTH; ++l) {
        transpose_matrix(F, FIN(7) + (size_t)l * DM * DFF, DM, DFF, lw(F, l, LW_GU1), 1, 0);
        transpose_matrix(F, FIN(8) + (size_t)l * DM * DFF, DM, DFF, lw(F, l, LW_GU1), 2, 0);
        transpose_matrix(F, FIN(9) + (size_t)l * DFF * DM, DFF, DM, lw(F, l, LW_D1), 0, 0);
        transpose_matrix(F, FIN(11) + (size_t)l * DM * NIN, DM, NIN, lw(F, l, LW_IN), 3, 0);
        transpose_matrix(F, FIN(19) + (size_t)l * 1024 * DM, 1024, DM, lw(F, l, LW_BR), 0, 0);
        transpose_matrix(F, FIN(20) + (size_t)l * 1024 * DM, 1024, DM, lw(F, l, LW_BR), 0, 2048);
        transpose_matrix(F, FIN(21) + (size_t)l * DM * DM, DM, DM, lw(F, l, LW_O), 0, 0);
        transpose_matrix(F, FIN(23) + (size_t)l * DM * DFF, DM, DFF, lw(F, l, LW_GU2), 1, 0);
        transpose_matrix(F, FIN(24) + (size_t)l * DM * DFF, DM, DFF, lw(F, l, LW_GU2), 2, 0);
        transpose_matrix(F, FIN(25) + (size_t)l * DFF * DM, DFF, DM, lw(F, l, LW_D2), 0, 0);
    }
    { float2* tab = (float2*)(F.ws + WS_TAB); const size_t gt = (size_t)blockIdx.x * 512 + F.tid, NT = (size_t)F.G * 512;
      for (size_t i = gt; i < (size_t)SEQ * 64; i += NT) { const int pos = (int)(i >> 6), dd = (int)(i & 63);
          double inv = 1.0; for (int k = 0; k < dd; ++k) inv *= 0.8659643233600653;
          const double ang = (double)pos * inv;
          const double kq = __builtin_rint(ang * 0.6366197723675814);
          double r = ang - kq * 1.5707963267948966; r -= kq * 6.123233995736766e-17;
          const double r2 = r * r;
          double s = r * (1.0 + r2 * (-1.0 / 6 + r2 * (1.0 / 120 + r2 * (-1.0 / 5040 + r2 * (1.0 / 362880 + r2 * (-1.0 / 39916800 + r2 * (1.0 / 6227020800.0)))))));
          double c = 1.0 + r2 * (-0.5 + r2 * (1.0 / 24 + r2 * (-1.0 / 720 + r2 * (1.0 / 40320 + r2 * (-1.0 / 3628800 + r2 * (1.0 / 479001600.0 + r2 * (-1.0 / 87178291200.0)))))));
          const int q = ((int)kq) & 3; double cs, sn;
          if (q == 0) { cs = c; sn = s; } else if (q == 1) { cs = -s; sn = c; } else if (q == 2) { cs = -c; sn = -s; } else { cs = s; sn = -c; }
          tab[i] = make_float2((float)cs, (float)sn); } }
}

__device__ __forceinline__ void rms_load_row(f32x4 (&v)[8], int m, int lane, int nslab, const float* xp, const float* xs, const bf16* XB, const float* XS, float* out) {
    if (m < MP && xp == nullptr) { const bf16* xb = XB + (size_t)m * DM;
#pragma unroll
        for (int j = 0; j < 8; ++j) { const u32x2 w = *(const u32x2*)(xb + 4 * lane + 256 * j); v[j] = (f32x4){bflo(w.x), bfhi(w.x), bflo(w.y), bfhi(w.y)}; }
    } else { const float* xr = (m < MP) ? xp + (size_t)m * DM : xs + (size_t)(m - MP) * DM;
#pragma unroll
        for (int j = 0; j < 8; ++j) v[j] = *(const f32x4*)(xr + 4 * lane + 256 * j); }
    if (m >= MP && nslab > 0) { float* xw = out + (size_t)m * DM;
        int s = 0;
#pragma unroll 1
        for (; s + 4 <= nslab; s += 4) { const float* sl = XS + ((size_t)s * MS + (m - MP)) * DM; f32x4 t[4][8];
#pragma unroll
            for (int q = 0; q < 4; ++q)
#pragma unroll
                for (int j = 0; j < 8; ++j) t[q][j] = *(const f32x4*)(sl + (size_t)q * MS * DM + 4 * lane + 256 * j);
#pragma unroll
            for (int j = 0; j < 8; ++j) v[j] += (t[0][j] + t[1][j]) + (t[2][j] + t[3][j]); }
#pragma unroll 1
        for (; s < nslab; ++s) { const float* sl = XS + ((size_t)s * MS + (m - MP)) * DM;
#pragma unroll
            for (int j = 0; j < 8; ++j) v[j] += *(const f32x4*)(sl + 4 * lane + 256 * j); }
#pragma unroll
        for (int j = 0; j < 8; ++j) *(f32x4*)(xw + 4 * lane + 256 * j) = v[j];
    }
}
__device__ __forceinline__ void rms_store_row(const f32x4 (&v)[8], const f32x4 (&g)[8], int m, int lane, bf16* H) {
    float ss = 0.f;
#pragma unroll
    for (int j = 0; j < 8; ++j) ss += (v[j][0] * v[j][0] + v[j][1] * v[j][1]) + (v[j][2] * v[j][2] + v[j][3] * v[j][3]);
    const float r = 1.0f / sqrtf(wave_sum(ss) * (1.0f / DM) + EPS);
    bf16* hr = H + (size_t)m * DM;
#pragma unroll
    for (int j = 0; j < 8; ++j) { u32x2 w; w.x = pk2(v[j][0] * r * g[j][0], v[j][1] * r * g[j][1]); w.y = pk2(v[j][2] * r * g[j][2], v[j][3] * r * g[j][3]); *(u32x2*)(hr + 4 * lane + 256 * j) = w; }
}
__device__ __forceinline__ void phase_rmsnorm(const Frame& F0, const float* gain, bf16* H, int nslab, const float* xp, const float* xs) {
    OPAQUE_FRAME(F);
    const float* XS = (const float*)(F.ws + WS_XS); const bf16* XB = (const bf16*)(F.ws + WS_XB);
    f32x4 g[8];
#pragma unroll
    for (int j = 0; j < 8; ++j) g[j] = *(const f32x4*)(gain + 4 * F.lane + 256 * j);
    for (int m0 = F.gw; m0 < MP; m0 += 4 * F.NGW) {
        const int m1 = m0 + F.NGW, m2 = m0 + 2 * F.NGW, m3 = m0 + 3 * F.NGW; f32x4 va[8], vb[8], vc[8], vd[8];
        rms_load_row(va, m0, F.lane, 0, xp, xs, XB, XS, F.out);
        if (m1 < MP) rms_load_row(vb, m1, F.lane, 0, xp, xs, XB, XS, F.out);
        if (m2 < MP) rms_load_row(vc, m2, F.lane, 0, xp, xs, XB, XS, F.out);
        if (m3 < MP) rms_load_row(vd, m3, F.lane, 0, xp, xs, XB, XS, F.out);
        rms_store_row(va, g, m0, F.lane, H);
        if (m1 < MP) rms_store_row(vb, g, m1, F.lane, H);
        if (m2 < MP) rms_store_row(vc, g, m2, F.lane, H);
        if (m3 < MP) rms_store_row(vd, g, m3, F.lane, H);
    }
    for (int m = MP + F.gw; m < M; m += F.NGW) {
        f32x4 va[8];
        rms_load_row(va, m, F.lane, nslab, xp, xs, XB, XS, F.out);
        rms_store_row(va, g, m, F.lane, H);
    }
}
__device__ __forceinline__ void phase_merge_sample(const Frame& F0) {
    OPAQUE_FRAME(F);
    const float* SL = (const float*)(F.ws + WS_XS); bf16* MRG = (bf16*)(F.ws + WS_MRG);
    for (int sm = F.gw; sm < MS; sm += F.NGW) {
#pragma unroll
        for (int j = 0; j < 8; ++j) { const size_t o = (size_t)sm * DM + 4 * F.lane + 256 * j;
            const f32x4 v = (*(const f32x4*)(SL + o) + *(const f32x4*)(SL + (size_t)MS * DM + o)) + (*(const f32x4*)(SL + (size_t)2 * MS * DM + o) + *(const f32x4*)(SL + (size_t)3 * MS * DM + o));
            u32x2 w; w.x = pk2(v[0], v[1]); w.y = pk2(v[2], v[3]); *(u32x2*)(MRG + (size_t)(MP + sm) * DM + 4 * F.lane + 256 * j) = w; }
    }
}
__device__ __forceinline__ void phase_final(const Frame& F0) {
    OPAQUE_FRAME(F);
    const float* XS = (const float*)(F.ws + WS_XS);
    for (int task = F.gw; task < MS * 8; task += F.NGW) {
        const int sm = task >> 3, j = task & 7; float* xr = F.out + (size_t)(MP + sm) * DM + 4 * F.lane + 256 * j; const float* sl = XS + (size_t)sm * DM + 4 * F.lane + 256 * j;
        f32x4 v = *(const f32x4*)xr, t[4];
#pragma unroll
        for (int s = 0; s < 4; ++s) t[s] = *(const f32x4*)(sl + (size_t)s * MS * DM);
#pragma unroll
        for (int s = 0; s < 4; ++s) v += t[s];
        *(f32x4*)xr = v;
    }
}
__device__ __forceinline__ void phase_rope(const Frame& F0, const Args& args, int l) {
    OPAQUE_FRAME(F);
    bf16* proj = (bf16*)(F.ws + WS_PROJ); bf16* QA = (bf16*)(F.ws + WS_QA); const float* PS = (const float*)(F.ws + WS_PS);
    const float2* tab = (const float2*)(F.ws + WS_TAB);
    const float gq1 = FIN(12)[l * 128 + F.lane], gq2 = FIN(12)[l * 128 + 64 + F.lane], gk1 = FIN(13)[l * 128 + F.lane], gk2 = FIN(13)[l * 128 + 64 + F.lane];
    for (int task = F.gw; task < MS * 8; task += F.NGW) {
        const int sm = task >> 3, part = task & 7;
        const int m = MP + sm, tt = sm & 31, pos = PAST + tt;
        bf16* pr = proj + (size_t)m * NIN; const float* ps = PS + (size_t)sm * NIN;
#define PSUM(c) (ps[(c)] + ps[(size_t)MS * NIN + (c)] + ps[(size_t)2 * MS * NIN + (c)] + ps[(size_t)3 * MS * NIN + (c)])
#define PSUM4(c) (*(const f32x4*)(ps + (c)) + *(const f32x4*)(ps + (size_t)MS * NIN + (c)) + *(const f32x4*)(ps + (size_t)2 * MS * NIN + (c)) + *(const f32x4*)(ps + (size_t)3 * MS * NIN + (c)))
        float* oak = F.out + O_AKS + ((size_t)l * MS + sm) * 1024; float* oav = F.out + O_AVS + ((size_t)l * MS + sm) * 1024;
        float* obk = F.out + O_BKS + ((size_t)l * MS + sm) * 1024; float* obv = F.out + O_BVS + ((size_t)l * MS + sm) * 1024;
        const size_t srow = (size_t)sm * 1024;
        if (part < 4) { const float2 cs = tab[pos * 64 + F.lane];
#pragma unroll
            for (int h2 = 0; h2 < 2; ++h2) { const int hh = 2 * part + h2;
                { const float x1 = PSUM(qk_phys(C_QA + hh * 128 + F.lane)), x2 = PSUM(qk_phys(C_QA + hh * 128 + 64 + F.lane));
                  const float r = 1.0f / sqrtf(wave_sum(x1 * x1 + x2 * x2) * (1.0f / 128) + EPS); const float y1 = x1 * r * gq1, y2 = x2 * r * gq2;
                  QA[(size_t)m * 1024 + hh * 128 + F.lane] = (bf16)f2bf(y1 * cs.x - y2 * cs.y); QA[(size_t)m * 1024 + hh * 128 + 64 + F.lane] = (bf16)f2bf(y2 * cs.x + y1 * cs.y); }
                { const float x1 = PSUM(qk_phys(C_KA + hh * 128 + F.lane)), x2 = PSUM(qk_phys(C_KA + hh * 128 + 64 + F.lane));
                  const float r = 1.0f / sqrtf(wave_sum(x1 * x1 + x2 * x2) * (1.0f / 128) + EPS); const float y1 = x1 * r * gk1, y2 = x2 * r * gk2;
                  const float o1 = y1 * cs.x - y2 * cs.y, o2 = y2 * cs.x + y1 * cs.y;
                  oak[hh * 128 + F.lane] = o1; oak[hh * 128 + 64 + F.lane] = o2;
                  bf16* d = skn(F, l, 0) + srow; d[hh * 128 + F.lane] = (bf16)f2bf(o1); d[hh * 128 + 64 + F.lane] = (bf16)f2bf(o2); } }
        } else if (part == 4) {
#pragma unroll
            for (int j = 0; j < 4; ++j) { const int c = 4 * F.lane + 256 * j; const f32x4 va = PSUM4(C_VA + c), kb = PSUM4(C_KB + c);
                *(f32x4*)(oav + c) = va; *(f32x4*)(obk + c) = kb;
                u32x2 w; w.x = pk2(va[0], va[1]); w.y = pk2(va[2], va[3]); *(u32x2*)(skn(F, l, 1) + srow + c) = w;
                w.x = pk2(kb[0], kb[1]); w.y = pk2(kb[2], kb[3]); *(u32x2*)(skn(F, l, 2) + srow + c) = w; }
        } else if (part == 5) {
#pragma unroll
            for (int j = 0; j < 4; ++j) { const int c = 4 * F.lane + 256 * j; const f32x4 vb = PSUM4(C_VB + c), qb = PSUM4(C_QB + c);
                *(f32x4*)(obv + c) = vb;
                u32x2 w; w.x = pk2(vb[0], vb[1]); w.y = pk2(vb[2], vb[3]); *(u32x2*)(skn(F, l, 3) + srow + c) = w;
                w.x = pk2(qb[0], qb[1]); w.y = pk2(qb[2], qb[3]); *(u32x2*)(pr + C_QB + c) = w; }
        } else {
#pragma unroll
            for (int j = 0; j < 8; ++j) { const int c = C_GA + 4 * F.lane + 256 * (j + 8 * (part - 6)); const f32x4 g = PSUM4(c);
                u32x2 w; w.x = pk2(g[0], g[1]); w.y = pk2(g[2], g[3]); *(u32x2*)(pr + c) = w; }
        }
#undef PSUM
#undef PSUM4
    }
}

__device__ __forceinline__ bf16x8 ld8(const bf16* p) { return *(const bf16x8*)p; }
__device__ __forceinline__ bf16x8 ldcol8(const bf16* p, size_t ld) { bf16x8 v;
#pragma unroll
    for (int j = 0; j < 8; ++j) v[j] = (short)p[(size_t)j * ld];
    return v; }
#define PK4(P, BASE, OUT) do { unsigned a0 = cvt_pk_bf16(P[BASE + 0], P[BASE + 1]), a1 = cvt_pk_bf16(P[BASE + 2], P[BASE + 3]);   \
    unsigned b0 = cvt_pk_bf16(P[BASE + 4], P[BASE + 5]), b1 = cvt_pk_bf16(P[BASE + 6], P[BASE + 7]);                              \
    auto r0 = __builtin_amdgcn_permlane32_swap(a0, b0, false, false); auto r1 = __builtin_amdgcn_permlane32_swap(a1, b1, false, false); \
    u32x4 w_ = {r0[0], r1[0], r0[1], r1[1]}; OUT = *reinterpret_cast<bf16x8*>(&w_); } while (0)
__device__ __forceinline__ int crow(int r, int hi) { return (r & 3) + 8 * (r >> 2) + 4 * hi; }
template <bool MASKED> __device__ __forceinline__ void stick32(f32x16& p, int kpos0, int qpos, int hi, float& carry) {
    constexpr float C = SM_SCALE * LOG2E;
    float Gs[4], Gp[4], Gt[4];
#pragma unroll
    for (int g = 0; g < 4; ++g) { float kp[4], be[4];
#pragma unroll
        for (int i = 0; i < 4; ++i) { const float u = __builtin_amdgcn_exp2f(fminf(p[4 * g + i] * C, 115.f)); const float k = __builtin_amdgcn_rcpf(1.0f + u);
            const bool v = !MASKED || (kpos0 + 8 * g + 4 * hi + i < qpos); kp[i] = v ? k : 1.f; be[i] = v ? u * k : 0.f; }
        const float w2 = kp[3], w1 = w2 * kp[2], w0 = w1 * kp[1]; Gs[g] = w0 * kp[0];
        p[4 * g + 3] = be[3]; p[4 * g + 2] = be[2] * w2; p[4 * g + 1] = be[1] * w1; p[4 * g] = be[0] * w0; }
#pragma unroll
    for (int g = 0; g < 4; ++g) { float x0, x1; half_swap(Gs[g], x0, x1); Gp[g] = hi ? x0 : x1; Gt[g] = x0 * x1; }
    float T[4]; float run = 1.f;
#pragma unroll
    for (int g = 3; g >= 0; --g) { T[g] = carry * run * (hi == 0 ? Gp[g] : 1.f); run *= Gt[g]; }
#pragma unroll
    for (int i = 0; i < 16; ++i) p[i] *= T[i >> 2];
    carry *= run;
}

__device__ __forceinline__ bf16x8 ld8f_o(const float* base, unsigned off) { const f32x4 a = *(const f32x4*)((const char*)base + off), b = *(const f32x4*)((const char*)base + off + 16u);
    u32x4 w = {cvt_pk_bf16(a[0], a[1]), cvt_pk_bf16(a[2], a[3]), cvt_pk_bf16(b[0], b[1]), cvt_pk_bf16(b[2], b[3])}; return *reinterpret_cast<bf16x8*>(&w); }
__device__ __forceinline__ bf16x8 ld8_o(const bf16* base, unsigned off) { return *(const bf16x8*)((const char*)base + off); }
__device__ __forceinline__ bf16x8 ldcol8f_o(const float* base, unsigned off) { float v[8];
#pragma unroll
    for (int j = 0; j < 8; ++j) v[j] = *(const float*)((const char*)base + off + (unsigned)j * 4096u);
    u32x4 w = {cvt_pk_bf16(v[0], v[1]), cvt_pk_bf16(v[2], v[3]), cvt_pk_bf16(v[4], v[5]), cvt_pk_bf16(v[6], v[7])}; return *reinterpret_cast<bf16x8*>(&w); }
__device__ __forceinline__ bf16x8 ldcol8_o(const bf16* base, unsigned off) { bf16x8 v;
#pragma unroll
    for (int j = 0; j < 8; ++j) v[j] = (short)*(const bf16*)((const char*)base + off + (unsigned)j * 2048u);
    return v; }
struct SampleKV { const float* Kc; const float* Vc; const bf16* Kn; const bf16* Vn; };
__device__ __forceinline__ void sample_scores(f32x16& p, const SampleKV& kv, int t, const bf16x8 (&qf)[8], int r, int h) {
#pragma unroll
    for (int i = 0; i < 16; ++i) p[i] = 0.f;
    if (t < 32) { unsigned off = (unsigned)((32 * t + r) * 1024 + 8 * h) * 4u; asm volatile("" : "+v"(off));
#pragma unroll
        for (int s = 0; s < 8; ++s) { p = __builtin_amdgcn_mfma_f32_32x32x16_bf16(ld8f_o(kv.Kc, off + 64u * s), qf[s], p, 0, 0, 0); }
    } else { unsigned off = (unsigned)(r * 1024 + 8 * h) * 2u; asm volatile("" : "+v"(off));
#pragma unroll
        for (int s = 0; s < 8; ++s) p = __builtin_amdgcn_mfma_f32_32x32x16_bf16(ld8_o(kv.Kn, off + 32u * s), qf[s], p, 0, 0, 0); }
}
__device__ __forceinline__ void sample_pv(f32x16 (&o)[4], const SampleKV& kv, int t, bf16x8 pa0, bf16x8 pa1, int r, int h) {
    if (t < 32) { unsigned off = (unsigned)((32 * t + 8 * h) * 1024 + r) * 4u; asm volatile("" : "+v"(off));
#pragma unroll
        for (int d = 0; d < 4; ++d) { const bf16x8 v0 = ldcol8f_o(kv.Vc, off + 128u * d), v1 = ldcol8f_o(kv.Vc, off + 128u * d + 16u * 4096u);
            o[d] = __builtin_amdgcn_mfma_f32_32x32x16_bf16(v0, pa0, o[d], 0, 0, 0); o[d] = __builtin_amdgcn_mfma_f32_32x32x16_bf16(v1, pa1, o[d], 0, 0, 0);
            }
    } else { unsigned off = (unsigned)((8 * h) * 1024 + r) * 2u; asm volatile("" : "+v"(off));
#pragma unroll
        for (int d = 0; d < 4; ++d) { const bf16x8 v0 = ldcol8_o(kv.Vn, off + 64u * d), v1 = ldcol8_o(kv.Vn, off + 64u * d + 16u * 2048u);
            o[d] = __builtin_amdgcn_mfma_f32_32x32x16_bf16(v0, pa0, o[d], 0, 0, 0); o[d] = __builtin_amdgcn_mfma_f32_32x32x16_bf16(v1, pa1, o[d], 0, 0, 0); } }
}
__device__ __forceinline__ void sample_v_dma(const SampleKV& kv, int t, LAS unsigned char* vbuf, int lane) {
    asm volatile("" ::: "memory");
    if (t < 32) { unsigned off = (unsigned)((32 * t + (lane >> 5)) * 1024 + 4 * (lane & 31)) * 4u; asm volatile("" : "+v"(off));
#pragma unroll
        for (int i = 0; i < 16; ++i) __builtin_amdgcn_global_load_lds((const unsigned*)((const char*)kv.Vc + off + (unsigned)i * 8192u), (LAS unsigned*)(vbuf + i * 1024), 16, 0, 0); }
    asm volatile("" ::: "memory");
}
__device__ __forceinline__ void sample_pv_any(f32x16 (&o)[4], const SampleKV& kv, int t, const LAS unsigned char* vbuf, bf16x8 pa0, bf16x8 pa1, int r, int h) {
    if (t < 32) {
        asm volatile("s_waitcnt vmcnt(0)" ::: "memory");
        const LAS float* vb = (const LAS float*)(vbuf + (8 * h) * 512 + r * 4);
#pragma unroll
        for (int d = 0; d < 4; ++d) { float a[8], b[8];
#pragma unroll
            for (int j = 0; j < 8; ++j) { a[j] = vb[j * 128 + d * 32]; b[j] = vb[(16 + j) * 128 + d * 32]; }
            u32x4 w0 = {cvt_pk_bf16(a[0], a[1]), cvt_pk_bf16(a[2], a[3]), cvt_pk_bf16(a[4], a[5]), cvt_pk_bf16(a[6], a[7])}, w1 = {cvt_pk_bf16(b[0], b[1]), cvt_pk_bf16(b[2], b[3]), cvt_pk_bf16(b[4], b[5]), cvt_pk_bf16(b[6], b[7])};
            o[d] = __builtin_amdgcn_mfma_f32_32x32x16_bf16(*reinterpret_cast<bf16x8*>(&w0), pa0, o[d], 0, 0, 0); o[d] = __builtin_amdgcn_mfma_f32_32x32x16_bf16(*reinterpret_cast<bf16x8*>(&w1), pa1, o[d], 0, 0, 0); }
        asm volatile("" ::: "memory");
    } else sample_pv(o, kv, t, pa0, pa1, r, h);
}
__device__ __forceinline__ void soft_range(const bf16* Q, int ldq, const SampleKV& kv, int t0, int t1, f32x16 (&o)[4], float& m_run, float& l_run, int lane, LAS unsigned char* vbuf) {
    const int r = lane & 31, h = lane >> 5;
    bf16x8 qf[8];
#pragma unroll
    for (int s = 0; s < 8; ++s) qf[s] = ld8(Q + (size_t)r * ldq + 16 * s + 8 * h);
#pragma unroll
    for (int d = 0; d < 4; ++d)
#pragma unroll
        for (int i = 0; i < 16; ++i) o[d][i] = 0.f;
    m_run = -1e30f; l_run = 0.f; const float C = SM_SCALE * LOG2E;
    for (int t = t0; t < t1; ++t) {
        sample_v_dma(kv, t, vbuf, lane);
        f32x16 p; sample_scores(p, kv, t, qf, r, h);
        float mx = p[0];
#pragma unroll
        for (int i = 1; i < 16; ++i) mx = fmaxf(mx, p[i]);
        mx = xor32_max(mx);
        const float mn = fmaxf(m_run, mx), alpha = __builtin_amdgcn_exp2f((m_run - mn) * C), mc = mn * C; m_run = mn;
        float sum = 0.f;
#pragma unroll
        for (int i = 0; i < 16; ++i) { p[i] = __builtin_amdgcn_exp2f(p[i] * C - mc); sum += p[i]; }
        sum = xor32_sum(sum);
        l_run = l_run * alpha + sum;
#pragma unroll
        for (int d = 0; d < 4; ++d)
#pragma unroll
            for (int i = 0; i < 16; ++i) o[d][i] *= alpha;
        bf16x8 pa0, pa1; PK4(p, 0, pa0); PK4(p, 8, pa1);
        sample_pv_any(o, kv, t, vbuf, pa0, pa1, r, h);
    }
}
__device__ __forceinline__ float stick_tile(const bf16x8 (&qf)[8], const SampleKV& kv, int t, f32x16 (&o)[4], int lane, LAS unsigned char* vbuf) {
    const int r = lane & 31, h = lane >> 5;
#pragma unroll
    for (int d = 0; d < 4; ++d)
#pragma unroll
        for (int i = 0; i < 16; ++i) o[d][i] = 0.f;
    float carry = 1.f;
    sample_v_dma(kv, t, vbuf, lane);
    f32x16 p; sample_scores(p, kv, t, qf, r, h);
    if (t == 32) stick32<true>(p, 0, r, h, carry); else stick32<false>(p, 0, r, h, carry);
    bf16x8 pa0, pa1; PK4(p, 0, pa0); PK4(p, 8, pa1);
    sample_pv_any(o, kv, t, vbuf, pa0, pa1, r, h);
    return carry;
}
constexpr int SML_OFF = 132096;
__device__ __forceinline__ void sampleA_item(const bf16* Q, SampleKV kv, int QQ, float* OP, float* ML, LAS unsigned char* lds, int tid_) {
    int tid = tid_; asm volatile("" : "+v"(tid));
    const int wid = __builtin_amdgcn_readfirstlane(tid >> 6), lane = tid & 63, r = lane & 31, h = lane >> 5, kq = wid & 3, vh = wid >> 2;
    LAS float* ml = (LAS float*)(lds + SML_OFF);
    kv.Vc += vh * 128; kv.Vn += vh * 128;
    { f32x16 o[4]; float m_run, l_run;
      const int tb = QQ == 0 ? 0 : 1 + 8 * QQ, tl = QQ == 0 ? 9 : 8;
      soft_range(Q, 1024, kv, tb + (kq * tl) / 4, tb + ((kq + 1) * tl) / 4, o, m_run, l_run, lane, lds + wid * 16384);
      LAS float* po = (LAS float*)(lds + wid * 16384);
#pragma unroll
      for (int d = 0; d < 4; ++d)
#pragma unroll
          for (int i = 0; i < 16; ++i) po[(d * 16 + i) * 64 + lane] = o[d][i];
      if (h == 0) { ml[wid * 64 + r] = m_run; ml[wid * 64 + 32 + r] = l_run; } }
    __syncthreads();
    { const float C = SM_SCALE * LOG2E; const int vh2 = tid >> 8, t8 = tid & 255, ln = t8 & 63, q = ln & 31, hh = ln >> 5, sub = t8 >> 6;
      float f[4], M_ = -1e30f, lt = 0.f;
#pragma unroll
      for (int j = 0; j < 4; ++j) M_ = fmaxf(M_, ml[(vh2 * 4 + j) * 64 + q]);
#pragma unroll
      for (int j = 0; j < 4; ++j) { f[j] = __builtin_amdgcn_exp2f((ml[(vh2 * 4 + j) * 64 + q] - M_) * C); lt += ml[(vh2 * 4 + j) * 64 + 32 + q] * f[j]; }
      if (tid < 32) { ML[q * 64] = M_; ML[q * 64 + 1] = lt; }
#pragma unroll 4
      for (int k = 0; k < 16; ++k) { const int di = k * 4 + sub, d = di >> 4, i = di & 15; float acc = 0.f;
#pragma unroll
          for (int j = 0; j < 4; ++j) acc += ((const LAS float*)(lds + (vh2 * 4 + j) * 16384))[di * 64 + ln] * f[j];
          OP[(size_t)q * 8192 + vh2 * 128 + 32 * d + (i & 3) + 8 * (i >> 2) + 4 * hh] = acc; } }
    __syncthreads();
}
__device__ __forceinline__ void sampleB_item(const bf16* Q, SampleKV kv, bf16* O, LAS unsigned char* lds, int tid_) {
    int tid = tid_; asm volatile("" : "+v"(tid));
    const int wid = __builtin_amdgcn_readfirstlane(tid >> 6), lane = tid & 63, r = lane & 31, h = lane >> 5;
    LAS float* ltot = (LAS float*)(lds + SML_OFF);
    const int q = lane & 31, hh = lane >> 5, sub = wid;
    bf16x8 qf[8];
#pragma unroll
    for (int s = 0; s < 8; ++s) qf[s] = ld8(Q + (size_t)r * NIN + 16 * s + 8 * h);
    float outv[8], Cprev = 1.f;
#pragma unroll
    for (int k = 0; k < 8; ++k) outv[k] = 0.f;
#pragma unroll 1
    for (int st = 0; st < 5; ++st) {
        const int t = (st < 4) ? 25 - 8 * st + wid : (wid == 0 ? 0 : -1);
        { f32x16 o[4]; float lt = 1.f;
          if (t >= 0) lt = stick_tile(qf, kv, t, o, lane, lds + wid * 16384);
          else {
#pragma unroll
              for (int d = 0; d < 4; ++d)
#pragma unroll
                  for (int i = 0; i < 16; ++i) o[d][i] = 0.f; }
          LAS float* po = (LAS float*)(lds + wid * 16384);
#pragma unroll
          for (int d = 0; d < 4; ++d)
#pragma unroll
              for (int i = 0; i < 16; ++i) po[(d * 16 + i) * 64 + lane] = o[d][i];
          if (h == 0) ltot[wid * 32 + r] = lt; }
        __syncthreads();
        float f[8]; float run = Cprev;
#pragma unroll
        for (int j = 7; j >= 0; --j) { f[j] = run; run *= ltot[j * 32 + q]; }
        Cprev = run;
#pragma unroll 2
        for (int k = 0; k < 8; ++k) { const int di = k * 8 + sub; float acc = 0.f;
#pragma unroll
            for (int j = 0; j < 8; ++j) acc += ((const LAS float*)(lds + j * 16384))[di * 64 + lane] * f[j];
            outv[k] += acc; }
        const bool done = __all(Cprev < 1e-30f);
        __syncthreads();
        if (done) break;
    }
#pragma unroll
    for (int k = 0; k < 8; ++k) { const int di = k * 8 + sub, d = di >> 4, i = di & 15;
        O[(size_t)q * 1024 + 32 * d + (i & 3) + 8 * (i >> 2) + 4 * hh] = (bf16)f2bf(outv[k]); }
}

namespace att {
#define KSWZ(row, colB) ((row) * 256 + ((colB) ^ (((row) & 7) << 4)))
#define SBAR() __builtin_amdgcn_sched_barrier(0)
typedef short s16x4 __attribute__((ext_vector_type(4)));
constexpr float THR = 8.f;
__device__ __forceinline__ void partialSM(f32x16& p0, f32x16& p1, float& m_reg, float& mn, float& alpha) {
    constexpr float C = SM_SCALE * LOG2E;
    float tm[16];
#pragma unroll
    for (int r = 0; r < 16; ++r) tm[r] = fmaxf(p0[r], p1[r]);
#pragma unroll
    for (int s = 8; s > 0; s >>= 1)
#pragma unroll
        for (int r = 0; r < s; ++r) tm[r] = fmaxf(tm[r], tm[r + s]);
    float pmax = xor32_max(tm[0]);
    if (__builtin_expect(__all(pmax - m_reg <= THR / SM_SCALE), 1)) { mn = m_reg; alpha = 1.f; }
    else { mn = fmaxf(m_reg, pmax); alpha = __builtin_amdgcn_exp2f((m_reg - mn) * C); m_reg = mn; }
    const float mnC = -mn * C;
#pragma unroll
    for (int r = 0; r < 16; ++r) p0[r] = fmaf(p0[r], C, mnC);
#pragma unroll
    for (int r = 0; r < 16; ++r) p1[r] = fmaf(p1[r], C, mnC);
#pragma unroll
    for (int r = 0; r < 16; ++r) p0[r] = __builtin_amdgcn_exp2f(p0[r]);
}
__device__ __forceinline__ void finishSM_noexp(f32x16& p0, f32x16& p1, float& l_reg, bf16x8& pa0, bf16x8& pa1, bf16x8& pa2, bf16x8& pa3) {
    float ts[16];
#pragma unroll
    for (int r = 0; r < 16; ++r) ts[r] = p0[r] + p1[r];
#pragma unroll
    for (int s = 8; s > 0; s >>= 1)
#pragma unroll
        for (int r = 0; r < s; ++r) ts[r] += ts[r + s];
    l_reg += xor32_sum(ts[0]);
    PK4(p0, 0, pa0); PK4(p0, 8, pa1); PK4(p1, 0, pa2); PK4(p1, 8, pa3);
}
__device__ __forceinline__ void finishSM(f32x16& p0, f32x16& p1, float alpha, float& l_reg, bf16x8& pa0, bf16x8& pa1, bf16x8& pa2, bf16x8& pa3) {
#pragma unroll
    for (int r = 0; r < 16; ++r) p1[r] = __builtin_amdgcn_exp2f(p1[r]);
    float ts[16];
#pragma unroll
    for (int r = 0; r < 16; ++r) ts[r] = p0[r] + p1[r];
#pragma unroll
    for (int s = 8; s > 0; s >>= 1)
#pragma unroll
        for (int r = 0; r < s; ++r) ts[r] += ts[r + s];
    float ps = xor32_sum(ts[0]);
    l_reg = l_reg * alpha + ps;
    PK4(p0, 0, pa0); PK4(p0, 8, pa1); PK4(p1, 0, pa2); PK4(p1, 8, pa3);
}
template <int KB> __device__ __forceinline__ void qkt(f32x16& p0, f32x16& p1, const LAS char* K_lds, const bf16x8 (&qr)[8], int r32, int hi) {
#pragma unroll
    for (int i = 0; i < 16; ++i) { p0[i] = 0.f; p1[i] = 0.f; }
    const LAS char* kb[4];
#pragma unroll
    for (int dd = 0; dd < 4; ++dd) kb[dd] = K_lds + KSWZ(r32, (dd * 16 + hi * 8) * 2);
#pragma unroll
    for (int d0 = 0; d0 < 8; ++d0) { const LAS char* a = kb[d0 & 3] + (d0 >> 2) * 128 + KB * 16384;
        const bf16x8 b0 = *(const LAS bf16x8*)a;
        const bf16x8 b1 = *(const LAS bf16x8*)(a + 32 * 256);
        p0 = __builtin_amdgcn_mfma_f32_32x32x16_bf16(b0, qr[d0], p0, 0, 0, 0);
        p1 = __builtin_amdgcn_mfma_f32_32x32x16_bf16(b1, qr[d0], p1, 0, 0, 0); }
}
__device__ __forceinline__ int v_st(int k, int c) { const int kk = (k & ~0xC) | ((k & 4) << 1) | ((k & 8) >> 1); return ((kk >> 3) * 4 + (c >> 5)) * 512 + ((kk & 7) * 32 + (c & 31)) * 2; }
__device__ __forceinline__ int v_rd_base(int lane) { return ((lane & 3) << 3) | (((lane >> 2) & 3) << 6) | (((lane >> 4) & 1) << 5) | (((lane >> 5) & 1) << 8); }
constexpr int v_rd_off(int vbuf, int d0, int ks, int half) { return vbuf * 32768 + d0 * 512 + ks * 4096 + half * 2048; }
template <int OFF> __device__ __forceinline__ s16x4 tr_read(int vb) { s16x4 r; asm volatile("ds_read_b64_tr_b16 %0, %1 offset:%2" : "=&v"(r) : "v"(vb), "i"(OFF) : "memory"); return r; }
template <int VB, int D0> __device__ __forceinline__ void pv_one(f32x16& od, int vb, bf16x8 pa0, bf16x8 pa1, bf16x8 pa2, bf16x8 pa3) {
    const s16x4 l0 = tr_read<v_rd_off(VB, D0, 0, 0)>(vb), h0 = tr_read<v_rd_off(VB, D0, 0, 1)>(vb), l1 = tr_read<v_rd_off(VB, D0, 1, 0)>(vb), h1 = tr_read<v_rd_off(VB, D0, 1, 1)>(vb);
    const s16x4 l2 = tr_read<v_rd_off(VB, D0, 2, 0)>(vb), h2 = tr_read<v_rd_off(VB, D0, 2, 1)>(vb), l3 = tr_read<v_rd_off(VB, D0, 3, 0)>(vb), h3 = tr_read<v_rd_off(VB, D0, 3, 1)>(vb);
    asm volatile("s_waitcnt lgkmcnt(0)" ::: "memory"); SBAR();
#define PKV(L, H) (bf16x8){L[0], L[1], L[2], L[3], H[0], H[1], H[2], H[3]}
    od = __builtin_amdgcn_mfma_f32_32x32x16_bf16(pa0, PKV(l0, h0), od, 0, 0, 0);
    od = __builtin_amdgcn_mfma_f32_32x32x16_bf16(pa1, PKV(l1, h1), od, 0, 0, 0);
    od = __builtin_amdgcn_mfma_f32_32x32x16_bf16(pa2, PKV(l2, h2), od, 0, 0, 0);
    od = __builtin_amdgcn_mfma_f32_32x32x16_bf16(pa3, PKV(l3, h3), od, 0, 0, 0);
#undef PKV
}
template <int VB> __device__ __forceinline__ void pv_d0(f32x16 (&o)[4], int vb, bf16x8 pa0, bf16x8 pa1, bf16x8 pa2, bf16x8 pa3) {
    pv_one<VB, 0>(o[0], vb, pa0, pa1, pa2, pa3); pv_one<VB, 1>(o[1], vb, pa0, pa1, pa2, pa3); pv_one<VB, 2>(o[2], vb, pa0, pa1, pa2, pa3); pv_one<VB, 3>(o[3], vb, pa0, pa1, pa2, pa3);
}
__device__ __forceinline__ void attnA_body(const bf16* __restrict__ Qb, const bf16* __restrict__ Kh, const bf16* __restrict__ Vh, float* __restrict__ Ob, int NT, LAS char* lds, int tid_) {
    int tid = tid_; asm volatile("" : "+v"(tid));
    const int wid = __builtin_amdgcn_readfirstlane(tid >> 6), lane = tid & 63, r32 = lane & 31, hi = lane >> 5, wq = wid & 3, vh = wid >> 2;
    const bool skip_last = wq < 2;
    LAS char* V_lds = lds; LAS char* K_lds = lds + 65536;
    LAS float* wsp = (LAS float*)(lds + 98304) + wid * 64; LAS float* li_l = wsp; LAS float* al_l = wsp + 32;
    float m_reg = -1e30f, l_reg = 0.f; f32x16 o[4]; bf16x8 qr[8];
#pragma unroll
    for (int d = 0; d < 4; ++d)
#pragma unroll
        for (int i = 0; i < 16; ++i) o[d][i] = 0.f;
    const bf16* Qw = Qb + (size_t)(wq * 32 + r32) * 1024 + hi * 8;
#pragma unroll
    for (int d0 = 0; d0 < 8; ++d0) qr[d0] = ld8(Qw + d0 * 16);
    const int sr = tid >> 4, sc = (tid & 15) * 8, vst0 = v_st(sr, sc), vst1 = v_st(32 + sr, sc);
    const int vb0 = (int)(uintptr_t)(V_lds + vh * 16384) + v_rd_base(lane);
    bf16x8 ks0, ks1, v00, v01, v10, v11;
    const unsigned kof = (unsigned)(sr * 1024 + sc) * 2u, vof = kof;
#define LDG(base, off) (*(const bf16x8*)((const char*)(base) + (off)))
#define SLOAD(k0) do { const unsigned kk_ = kof + (unsigned)(k0) * 2048u, vv_ = vof + (unsigned)(k0) * 2048u; ks0 = LDG(Kh, kk_); ks1 = LDG(Kh, kk_ + 32u * 2048u); \
    v00 = LDG(Vh, vv_); v01 = LDG(Vh, vv_ + 256u); v10 = LDG(Vh, vv_ + 32u * 2048u); v11 = LDG(Vh, vv_ + 32u * 2048u + 256u); } while (0)
#define SWRITE(b) do { *(LAS bf16x8*)(V_lds + (b) * 32768 + vst0) = v00; *(LAS bf16x8*)(V_lds + (b) * 32768 + 16384 + vst0) = v01; *(LAS bf16x8*)(V_lds + (b) * 32768 + vst1) = v10; *(LAS bf16x8*)(V_lds + (b) * 32768 + 16384 + vst1) = v11; \
    *(LAS bf16x8*)(K_lds + (b) * 16384 + KSWZ(sr, sc * 2)) = ks0; *(LAS bf16x8*)(K_lds + (b) * 16384 + KSWZ(32 + sr, sc * 2)) = ks1; } while (0)
#define SWAIT() asm volatile("s_waitcnt vmcnt(0)" ::: "memory")
#define RESC(a) do { if (__any((a) < 1.f)) { if (hi == 0) al_l[r32] = (a); asm volatile("s_waitcnt lgkmcnt(0)" ::: "memory"); \
    _Pragma("unroll") for (int d = 0; d < 4; ++d) _Pragma("unroll") for (int r = 0; r < 16; ++r) o[d][r] *= al_l[crow(r, hi)]; } } while (0)
    f32x16 pA0, pA1, pB0, pB1; float mnA, mnB, alA, alB; bf16x8 pa0, pa1, pa2, pa3;
    SLOAD(0); SWAIT(); SWRITE(0); __syncthreads();
    qkt<0>(pA0, pA1, K_lds, qr, r32, hi); partialSM(pA0, pA1, m_reg, mnA, alA);
    SLOAD(64); SWAIT(); SWRITE(1); __syncthreads();
    for (int j = 1; j + 1 < NT; j += 2) {
        SBAR(); SLOAD((j + 1) * 64); SBAR();
        qkt<1>(pB0, pB1, K_lds, qr, r32, hi);
        finishSM(pA0, pA1, alA, l_reg, pa0, pa1, pa2, pa3); SBAR();
        pv_d0<0>(o, vb0, pa0, pa1, pa2, pa3); partialSM(pB0, pB1, m_reg, mnB, alB);
        __syncthreads(); SWAIT(); SWRITE(0);
        RESC(alB); __syncthreads();
        SBAR(); SLOAD((j + 2) * 64); SBAR();
        qkt<0>(pA0, pA1, K_lds, qr, r32, hi);
        finishSM(pB0, pB1, alB, l_reg, pa0, pa1, pa2, pa3); SBAR();
        pv_d0<1>(o, vb0, pa0, pa1, pa2, pa3); partialSM(pA0, pA1, m_reg, mnA, alA);
        __syncthreads(); SWAIT(); SWRITE(1);
        RESC(alA); __syncthreads();
    }
    SBAR(); if (!skip_last) qkt<1>(pB0, pB1, K_lds, qr, r32, hi);
    finishSM(pA0, pA1, alA, l_reg, pa0, pa1, pa2, pa3); SBAR();
    pv_d0<0>(o, vb0, pa0, pa1, pa2, pa3);
    if (!skip_last) { partialSM(pB0, pB1, m_reg, mnB, alB); RESC(alB); finishSM(pB0, pB1, alB, l_reg, pa0, pa1, pa2, pa3); SBAR(); pv_d0<1>(o, vb0, pa0, pa1, pa2, pa3); }
    if (hi == 0) li_l[r32] = l_reg; asm volatile("s_waitcnt lgkmcnt(0)" ::: "memory");
    float rli[16];
#pragma unroll
    for (int r = 0; r < 16; ++r) rli[r] = __builtin_amdgcn_rcpf(li_l[crow(r, hi)]);
    float* Ow = Ob + (size_t)(wq * 32) * 2048 + vh * 128;
#pragma unroll
    for (int r = 0; r < 16; ++r) { const int orow = crow(r, hi);
#pragma unroll
        for (int d0 = 0; d0 < 4; ++d0) Ow[(size_t)orow * 2048 + d0 * 32 + r32] = o[d0][r] * rli[r]; }
    __syncthreads();
#undef SLOAD
#undef SWRITE
}
template <int OFF> __device__ __forceinline__ void tr_read8(s16x4 (&v)[8], int vb) {
    v[0] = tr_read<OFF>(vb); v[1] = tr_read<OFF + 2048>(vb); v[2] = tr_read<OFF + 4096>(vb); v[3] = tr_read<OFF + 6144>(vb);
    v[4] = tr_read<OFF + 8192>(vb); v[5] = tr_read<OFF + 10240>(vb); v[6] = tr_read<OFF + 12288>(vb); v[7] = tr_read<OFF + 14336>(vb);
}
#define PKV(L, H) (bf16x8){L[0], L[1], L[2], L[3], H[0], H[1], H[2], H[3]}
#define PV_MMA(od, v) do { od = __builtin_amdgcn_mfma_f32_32x32x16_bf16(pa0, PKV(v[0], v[1]), od, 0, 0, 0); od = __builtin_amdgcn_mfma_f32_32x32x16_bf16(pa1, PKV(v[2], v[3]), od, 0, 0, 0); \
    od = __builtin_amdgcn_mfma_f32_32x32x16_bf16(pa2, PKV(v[4], v[5]), od, 0, 0, 0); od = __builtin_amdgcn_mfma_f32_32x32x16_bf16(pa3, PKV(v[6], v[7]), od, 0, 0, 0); } while (0)
#define PV_OFF(VB, D0) ((VB) * 32768 + ((D0) >> 2) * 16384 + ((D0) & 3) * 512)
template <int VB> __device__ __forceinline__ void pv8(f32x16 (&o)[8], int vb, bf16x8 pa0, bf16x8 pa1, bf16x8 pa2, bf16x8 pa3) {
    s16x4 va[8], vbb[8];
    tr_read8<PV_OFF(VB, 0)>(va, vb);
    tr_read8<PV_OFF(VB, 1)>(vbb, vb); asm volatile("s_waitcnt lgkmcnt(8)" ::: "memory"); SBAR(); PV_MMA(o[0], va);
    tr_read8<PV_OFF(VB, 2)>(va, vb);  asm volatile("s_waitcnt lgkmcnt(8)" ::: "memory"); SBAR(); PV_MMA(o[1], vbb);
    tr_read8<PV_OFF(VB, 3)>(vbb, vb); asm volatile("s_waitcnt lgkmcnt(8)" ::: "memory"); SBAR(); PV_MMA(o[2], va);
    tr_read8<PV_OFF(VB, 4)>(va, vb);  asm volatile("s_waitcnt lgkmcnt(8)" ::: "memory"); SBAR(); PV_MMA(o[3], vbb);
    tr_read8<PV_OFF(VB, 5)>(vbb, vb); asm volatile("s_waitcnt lgkmcnt(8)" ::: "memory"); SBAR(); PV_MMA(o[4], va);
    tr_read8<PV_OFF(VB, 6)>(va, vb);  asm volatile("s_waitcnt lgkmcnt(8)" ::: "memory"); SBAR(); PV_MMA(o[5], vbb);
    tr_read8<PV_OFF(VB, 7)>(vbb, vb); asm volatile("s_waitcnt lgkmcnt(8)" ::: "memory"); SBAR(); PV_MMA(o[6], va);
    asm volatile("s_waitcnt lgkmcnt(0)" ::: "memory"); SBAR(); PV_MMA(o[7], vbb);
}
#undef PKV
#undef PV_MMA
#undef PV_OFF
__device__ __forceinline__ void attnA2_body(const bf16* __restrict__ Qb, const bf16* __restrict__ Kh, const bf16* __restrict__ Vh, float* __restrict__ Ob, int NT, float shiftC, LAS char* lds, int tid_) {
    int tid = tid_; asm volatile("" : "+v"(tid));
    const int wid = __builtin_amdgcn_readfirstlane(tid >> 6), lane = tid & 63, r32 = lane & 31, hi = lane >> 5, rg = wid & 3;
    const bool isS = wid < 4, skip_last = rg < 2;
    LAS char* K_lds = lds; LAS char* V_lds = lds + 32768; LAS char* P_l = lds + 98304 + rg * 4096 + lane * 16;
    LAS float* al_l = (LAS float*)(lds + pg8::XCH_OFF) + rg * 32; LAS unsigned* fl_l = (LAS unsigned*)(lds + pg8::XCH_OFF + 1024) + rg; LAS float* li_l = (LAS float*)(lds + pg8::XCH_OFF + 2048) + rg * 32;
    if (isS) {
        float m_reg = -1e30f, l_reg = 0.f; bf16x8 qr[8];
        const unsigned lq_ = (unsigned)lane >> 4, lc_ = (unsigned)lane & 15u, r8_ = ((unsigned)lane & 31u) >> 2;
        const unsigned kofE = lq_ * 2048u + ((lc_ ^ lq_) << 4), kofO = lq_ * 2048u + ((lc_ ^ (lq_ + 4u)) << 4);
        const unsigned vofL = ((r8_ >> 2) * 8u + (r8_ & 3u)) * 2048u + ((unsigned)lane >> 5) * 64u + ((unsigned)lane & 3u) * 16u;
#define A2_DMAK(t_, b) do { _Pragma("unroll") for (int q_ = 0; q_ < 4; ++q_) { const int i_ = 4 * rg + q_; \
            __builtin_amdgcn_global_load_lds((const unsigned*)((const char*)Kh + ((unsigned)(t_) * (64u * 2048u) + (unsigned)i_ * (4u * 2048u) + ((q_ & 1) ? kofO : kofE))), (LAS unsigned*)(K_lds + (b) * 16384 + i_ * 1024), 16, 0, 0); } } while (0)
#define A2_DMAV(t_, b) do { _Pragma("unroll") for (int q_ = 0; q_ < 8; ++q_) { const int j_ = 8 * rg + q_, J_ = 4 * (rg & 1) + (q_ >> 1); \
            const unsigned po_ = (unsigned)((J_ >> 1) * 16 + (J_ & 1) * 4) * 2048u + (unsigned)(q_ & 1) * 128u + (unsigned)(rg >> 1) * 256u; \
            __builtin_amdgcn_global_load_lds((const unsigned*)((const char*)Vh + ((unsigned)(t_) * (64u * 2048u) + po_ + vofL)), (LAS unsigned*)(V_lds + (b) * 32768 + j_ * 1024), 16, 0, 0); } } while (0)
#define A2_STAGE(PAR, t_) do { if ((t_) + 1 < NT) A2_DMAK((t_) + 1, (PAR) ^ 1); if ((t_) < NT) A2_DMAV((t_), PAR); } while (0)
#define A2_LANDED() asm volatile("s_waitcnt vmcnt(0)" ::: "memory")
        A2_DMAK(0, 0);
        const bf16* Qw = Qb + (size_t)(rg * 32 + r32) * 1024 + hi * 8;
#pragma unroll
        for (int d0 = 0; d0 < 8; ++d0) qr[d0] = ld8(Qw + d0 * 16);
        A2_LANDED();
        __syncthreads();
#define A2_SSTEP_FAST(PAR, t_) do { A2_STAGE(PAR, t_); \
        if ((t_) < NT && !(skip_last && (t_) == NT - 1)) { f32x16 p0, p1; bf16x8 pa0, pa1, pa2, pa3; constexpr float C = SM_SCALE * LOG2E; \
            qkt<PAR>(p0, p1, K_lds, qr, r32, hi); \
            _Pragma("unroll") for (int r = 0; r < 16; ++r) { p0[r] = __builtin_amdgcn_exp2f(fmaf(p0[r], C, -shiftC)); p1[r] = __builtin_amdgcn_exp2f(fmaf(p1[r], C, -shiftC)); } \
            finishSM_noexp(p0, p1, l_reg, pa0, pa1, pa2, pa3); \
            *(LAS bf16x8*)(P_l + (PAR) * 16384) = pa0; *(LAS bf16x8*)(P_l + (PAR) * 16384 + 1024) = pa1; *(LAS bf16x8*)(P_l + (PAR) * 16384 + 2048) = pa2; *(LAS bf16x8*)(P_l + (PAR) * 16384 + 3072) = pa3; } \
        if ((t_) == NT && hi == 0) li_l[r32] = __builtin_amdgcn_rcpf(l_reg); \
        A2_LANDED(); __syncthreads(); } while (0)
#define A2_SSTEP(PAR, t_) do { A2_STAGE(PAR, t_); \
        if ((t_) < NT && !(skip_last && (t_) == NT - 1)) { f32x16 p0, p1; float mn, alpha; bf16x8 pa0, pa1, pa2, pa3; \
            qkt<PAR>(p0, p1, K_lds, qr, r32, hi); partialSM(p0, p1, m_reg, mn, alpha); finishSM(p0, p1, alpha, l_reg, pa0, pa1, pa2, pa3); \
            *(LAS bf16x8*)(P_l + (PAR) * 16384) = pa0; *(LAS bf16x8*)(P_l + (PAR) * 16384 + 1024) = pa1; *(LAS bf16x8*)(P_l + (PAR) * 16384 + 2048) = pa2; *(LAS bf16x8*)(P_l + (PAR) * 16384 + 3072) = pa3; \
            const bool resc = __any(alpha < 1.f); if (resc && hi == 0) al_l[(PAR) * 128 + r32] = alpha; if (lane == 0) fl_l[(PAR) * 4] = resc ? 1u : 0u; } \
        if ((t_) == NT && hi == 0) li_l[r32] = __builtin_amdgcn_rcpf(l_reg); \
        A2_LANDED(); __syncthreads(); } while (0)
        if (shiftC > 0.f) { for (int t = 0; t <= NT; t += 2) { A2_SSTEP_FAST(0, t); if (t + 1 <= NT) A2_SSTEP_FAST(1, t + 1); } }
        else { for (int t = 0; t <= NT; t += 2) { A2_SSTEP(0, t); if (t + 1 <= NT) A2_SSTEP(1, t + 1); } }
#undef A2_SSTEP
#undef A2_SSTEP_FAST
#undef A2_STAGE
#undef A2_LANDED
#undef A2_DMAK
#undef A2_DMAV
    } else {
        f32x16 o[8];
#pragma unroll
        for (int d = 0; d < 8; ++d)
#pragma unroll
            for (int i = 0; i < 16; ++i) o[d][i] = 0.f;
        const int vb0 = (int)(uintptr_t)V_lds + v_rd_base(lane);
        __syncthreads();
#define A2_PSTEP(PAR, t_) do { \
        if ((t_) >= 1 && !(skip_last && (t_) == NT)) { constexpr int PJ = (PAR) ^ 1; \
            const bf16x8 pa0 = *(const LAS bf16x8*)(P_l + PJ * 16384), pa1 = *(const LAS bf16x8*)(P_l + PJ * 16384 + 1024), pa2 = *(const LAS bf16x8*)(P_l + PJ * 16384 + 2048), pa3 = *(const LAS bf16x8*)(P_l + PJ * 16384 + 3072); \
            if (shiftC <= 0.f && __builtin_amdgcn_readfirstlane((int)fl_l[PJ * 4]) != 0) { \
                _Pragma("unroll") for (int r = 0; r < 16; ++r) { const float a = al_l[PJ * 128 + crow(r, hi)]; _Pragma("unroll") for (int d = 0; d < 8; ++d) o[d][r] *= a; } } \
            asm volatile("" :: "v"(pa0), "v"(pa1), "v"(pa2), "v"(pa3));     \
            pv8<PJ>(o, vb0, pa0, pa1, pa2, pa3); } \
        __syncthreads(); } while (0)
        for (int t = 0; t <= NT; t += 2) { A2_PSTEP(0, t); if (t + 1 <= NT) A2_PSTEP(1, t + 1); }
#undef A2_PSTEP
        float rli[16];
#pragma unroll
        for (int r = 0; r < 16; ++r) rli[r] = li_l[crow(r, hi)];
        float* Ow = Ob + (size_t)(rg * 32) * 2048;
#pragma unroll
        for (int r = 0; r < 16; ++r) { const int orow = crow(r, hi);
#pragma unroll
            for (int d0 = 0; d0 < 8; ++d0) Ow[(size_t)orow * 2048 + d0 * 32 + r32] = o[d0][r] * rli[r]; }
    }
    __syncthreads();
}
__device__ __forceinline__ void attnB_body(const bf16* __restrict__ Qb, const bf16* __restrict__ Kh, const bf16* __restrict__ Vh, bf16* __restrict__ Ob, int q0, LAS char* lds, int tid_) {
    int tid = tid_; asm volatile("" : "+v"(tid));
    const int wid = __builtin_amdgcn_readfirstlane(tid >> 6), lane = tid & 63, r32 = lane & 31, hi = lane >> 5;
    LAS char* V_lds = lds; LAS char* K_lds = lds + 65536; volatile LAS unsigned* flg = (volatile LAS unsigned*)(lds + 100352);
    f32x16 o[4]; bf16x8 qr[8];
#pragma unroll
    for (int d = 0; d < 4; ++d)
#pragma unroll
        for (int i = 0; i < 16; ++i) o[d][i] = 0.f;
    const bf16* Qw = Qb + (size_t)(wid * 32 + r32) * NIN + hi * 8;
#pragma unroll
    for (int d0 = 0; d0 < 8; ++d0) qr[d0] = ld8(Qw + d0 * 16);
    const int sr = tid >> 4, sc = (tid & 15) * 8, vst0 = v_st(sr, sc), vst1 = v_st(32 + sr, sc);
    const int vb0 = (int)(uintptr_t)V_lds + v_rd_base(lane);
    const int qfirst = q0 + 32 * wid, qpos = qfirst + r32;
    bf16x8 ks0, ks1, v00, v10;
    const unsigned kvof = (unsigned)(sr * NIN + sc) * 2u;
#define SLOAD(k0) do { const unsigned kk_ = kvof + (unsigned)(k0) * (NIN * 2u); ks0 = LDG(Kh, kk_); ks1 = LDG(Kh, kk_ + 32u * NIN * 2u); v00 = LDG(Vh, kk_); v10 = LDG(Vh, kk_ + 32u * NIN * 2u); } while (0)
#define SWRITE(b) do { *(LAS bf16x8*)(V_lds + (b) * 32768 + vst0) = v00; *(LAS bf16x8*)(V_lds + (b) * 32768 + vst1) = v10; \
    *(LAS bf16x8*)(K_lds + (b) * 16384 + KSWZ(sr, sc * 2)) = ks0; *(LAS bf16x8*)(K_lds + (b) * 16384 + KSWZ(32 + sr, sc * 2)) = ks1; } while (0)
    float carry = 1.f; bool wdone = false;
    const int t_hi = (q0 + 255) >> 6;
    SLOAD(t_hi * 64); SWAIT(); SWRITE(0); __syncthreads();
#define BSTEP(CUR) { \
        if (t > 0) SLOAD((t - 1) * 64); \
        if (!wdone && 64 * t < qfirst + 31) {                \
            f32x16 p0, p1; qkt<CUR>(p0, p1, K_lds, qr, r32, hi); \
            if (64 * t + 63 >= qfirst) { stick32<true>(p1, 64 * t + 32, qpos, hi, carry); stick32<true>(p0, 64 * t, qpos, hi, carry); } \
            else { stick32<false>(p1, 0, 0, hi, carry); stick32<false>(p0, 0, 0, hi, carry); } \
            bf16x8 pa0, pa1, pa2, pa3; PK4(p0, 0, pa0); PK4(p0, 8, pa1); PK4(p1, 0, pa2); PK4(p1, 8, pa3); \
            pv_d0<CUR>(o, vb0, pa0, pa1, pa2, pa3); \
            wdone = __all(carry < 1e-30f); \
        } \
        if (lane == 0) flg[CUR * 8 + wid] = wdone ? 1u : 0u; \
        if (t > 0) { SWAIT(); SWRITE(CUR ^ 1); } \
        __syncthreads(); \
        if (t == 0) break; \
        if (__all(flg[CUR * 8 + (lane & 7)] != 0u)) break; \
        --t; }
    for (int t = t_hi;;) { BSTEP(0) BSTEP(1) }
#undef BSTEP
    bf16* Ow = Ob + (size_t)(wid * 32) * 1024;
#pragma unroll
    for (int r = 0; r < 16; ++r) { const int orow = crow(r, hi);
#pragma unroll
        for (int d0 = 0; d0 < 4; ++d0) Ow[(size_t)orow * 1024 + d0 * 32 + r32] = (bf16)f2bf(o[d0][r]); }
    __syncthreads();
#undef SLOAD
#undef SWRITE
#undef SWAIT
#undef RESC
}
}

__device__ __forceinline__ void phase_attention(const Frame& F0, const Args& args, int l) {
    OPAQUE_FRAME(F);
    const bf16* proj = (const bf16*)(F.ws + WS_PROJ); const bf16* QA = (const bf16*)(F.ws + WS_QA); const bf16* KA = (const bf16*)(F.ws + WS_KA);
    float* OS = (float*)(F.ws + WS_OS); bf16* OB = (bf16*)(F.ws + WS_OB); const bf16* VA = (const bf16*)(F.ws + WS_VA);
    const int c = blockIdx.x;
    float shiftC;
    { float gqm = fmaxf(fabsf(FIN(12)[l * 128 + F.lane]), fabsf(FIN(12)[l * 128 + 64 + F.lane])), gkm = fmaxf(fabsf(FIN(13)[l * 128 + F.lane]), fabsf(FIN(13)[l * 128 + 64 + F.lane]));
      gqm = fmaxf(gqm, swz_xor<1>(gqm)); gqm = fmaxf(gqm, swz_xor<2>(gqm)); gqm = fmaxf(gqm, swz_xor<4>(gqm)); gqm = fmaxf(gqm, swz_xor<8>(gqm)); gqm = fmaxf(gqm, swz_xor<16>(gqm)); gqm = xor32_max(gqm);
      gkm = fmaxf(gkm, swz_xor<1>(gkm)); gkm = fmaxf(gkm, swz_xor<2>(gkm)); gkm = fmaxf(gkm, swz_xor<4>(gkm)); gkm = fmaxf(gkm, swz_xor<8>(gkm)); gkm = fmaxf(gkm, swz_xor<16>(gkm)); gkm = xor32_max(gkm);
      const float B = 11.3137085f * 1.01f * gqm * gkm; shiftC = (B <= 30.f) ? B * LOG2E : 0.f; shiftC = __builtin_bit_cast(float, __builtin_amdgcn_readfirstlane(__builtin_bit_cast(int, shiftC))); }
#pragma unroll 1
    for (int st = 0; st < 4; ++st) {
        const int sel = (c & 1) ? ((st + 3) & 3) : st;
        if (sel == 0) {
            float* SPO = (float*)(F.ws + WS_PS); float* SPM = SPO + (size_t)MS * 8 * 4 * 256;
            for (int it = c; it < 256; it += F.G) {
                const int QQ = it & 3, x = (it >> 2) & 7, b = it >> 5, m0 = MP + 32 * b; const size_t crow0 = ((size_t)(l * DECB + b) * PAST) * 1024, nrow0 = (size_t)(32 * b) * 1024;
                const SampleKV kv{FIN(2) + crow0 + x * 128, FIN(3) + crow0 + (x >> 1) * 256, skn(F, l, 0) + nrow0 + x * 128, skn(F, l, 1) + nrow0 + (x >> 1) * 256};
                const size_t pi = ((size_t)(32 * b) * 8 + x) * 4 + QQ;
                sampleA_item(QA + (size_t)m0 * 1024 + x * 128, kv, QQ, SPO + pi * 256, SPM + pi * 2, F.lds, F.tid);
            }
        } else if (sel == 1) {
            for (int it = c; it < 64; it += F.G) {
                const int b = it >> 3, x = it & 7, m0 = MP + 32 * b; const size_t crow0 = ((size_t)(l * DECB + b) * PAST) * 1024, nrow0 = (size_t)(32 * b) * 1024;
                const SampleKV kv{FIN(4) + crow0 + x * 128, FIN(5) + crow0 + x * 128, skn(F, l, 2) + nrow0 + x * 128, skn(F, l, 3) + nrow0 + x * 128};
                sampleB_item(proj + (size_t)m0 * NIN + C_QB + x * 128, kv, OB + (size_t)m0 * 1024 + x * 128, F.lds, F.tid);
            }
        } else if (sel == 2) {
            for (int it = c; it < 256; it += F.G) {
                const int s = it & 7, bp = it >> 3;
        #pragma unroll 1
                for (int k = 0; k < 2; ++k) { const int qb = k == 0 ? 63 - bp : bp; const int m0 = 128 * qb;
                    att::attnA2_body(QA + (size_t)m0 * 1024 + s * 128, KA + s * 128, VA + (s >> 1) * 256, OS + (size_t)m0 * 2048 + s * 256, 2 * qb + 2, shiftC, (LAS char*)F.lds, F.tid); }
            }
        } else {
            for (int it = c; it < 256; it += F.G) {
                const int hd = it & 7, qb = it >> 3, m0 = 256 * qb;
                att::attnB_body(proj + (size_t)m0 * NIN + C_QB + hd * 128, proj + C_KB + hd * 128, proj + C_VB + hd * 128, OB + (size_t)m0 * 1024 + hd * 128, m0, (LAS char*)F.lds, F.tid);
            }
        }
    }
}

__device__ __forceinline__ float lam_of(Frame& F, const Args& args, int l) {
    const float a = wave_sum(FIN(14)[l * 128 + F.lane] * FIN(15)[l * 128 + F.lane] + FIN(14)[l * 128 + 64 + F.lane] * FIN(15)[l * 128 + 64 + F.lane]);
    const float b = wave_sum(FIN(16)[l * 128 + F.lane] * FIN(17)[l * 128 + F.lane] + FIN(16)[l * 128 + 64 + F.lane] * FIN(17)[l * 128 + 64 + F.lane]);
    const float lam_init = (l == 0) ? 0.2f : 0.35550906759096934f;
    return __expf(a) - __expf(b) + lam_init;
}
__device__ __forceinline__ void phase_combine(const Frame& F0, const Args& args, int l) {
    OPAQUE_FRAME(F);
    const float* OS = (const float*)(F.ws + WS_OS); bf16* OA = (bf16*)(F.ws + WS_OA);
    const float lam = lam_of(F, args, l), post = 1.0f - ((l == 0) ? 0.2f : 0.35550906759096934f);
    const f32x4 g = *(const f32x4*)(FIN(18) + l * 256 + 4 * F.lane);
    for (int it0 = F.gw; it0 < MP * 4; it0 += 4 * F.NGW) {
        f32x4 a[4], b[4];
#pragma unroll
        for (int q = 0; q < 4; ++q) { const int it = it0 + q * F.NGW; if (it < MP * 4) { const int m = it >> 2, hA = it & 3;
            a[q] = *(const f32x4*)(OS + (size_t)m * 2048 + (2 * hA) * 256 + 4 * F.lane); b[q] = *(const f32x4*)(OS + (size_t)m * 2048 + (2 * hA + 1) * 256 + 4 * F.lane); } else { a[q] = (f32x4){0.f, 0.f, 0.f, 0.f}; b[q] = a[q]; } }
#pragma unroll
        for (int q = 0; q < 4; ++q) { const int it = it0 + q * F.NGW; const int m = it >> 2, hA = it & 3;
            const f32x4 d = a[q] - b[q] * lam; const float ss = wave_sum((d[0] * d[0] + d[1] * d[1]) + (d[2] * d[2] + d[3] * d[3]));
            const float r = post / sqrtf(ss * (1.0f / 256) + EPS);
            u32x2 w; w.x = pk2(d[0] * r * g[0], d[1] * r * g[1]); w.y = pk2(d[2] * r * g[2], d[3] * r * g[3]);
            if (it < MP * 4) *(u32x2*)(OA + (size_t)m * 1024 + hA * 256 + 4 * F.lane) = w; }
    }
    const float* SPO = (const float*)(F.ws + WS_PS); const float* SPM = SPO + (size_t)MS * 8 * 4 * 256; const float C = SM_SCALE * LOG2E;
    for (int it = F.gw; it < MS * 4; it += F.NGW) { const int sm = it >> 2, hA = it & 3; f32x4 ab[2];
        f32x4 o[2][4]; float mm[2][4], ll[2][4];
#pragma unroll
        for (int e = 0; e < 2; ++e)
#pragma unroll
            for (int j = 0; j < 4; ++j) { const size_t pi = ((size_t)sm * 8 + 2 * hA + e) * 4 + j; o[e][j] = *(const f32x4*)(SPO + pi * 256 + 4 * F.lane); mm[e][j] = SPM[pi * 2]; ll[e][j] = SPM[pi * 2 + 1]; }
#pragma unroll
        for (int e = 0; e < 2; ++e) { const float Mx = fmaxf(fmaxf(mm[e][0], mm[e][1]), fmaxf(mm[e][2], mm[e][3])); float L = 0.f; f32x4 acc = {0.f, 0.f, 0.f, 0.f};
#pragma unroll
            for (int j = 0; j < 4; ++j) { const float w = __builtin_amdgcn_exp2f((mm[e][j] - Mx) * C); L += w * ll[e][j]; acc += o[e][j] * w; }
            ab[e] = acc * (1.0f / L); }
        const f32x4 d = ab[0] - ab[1] * lam; const float ss = wave_sum((d[0] * d[0] + d[1] * d[1]) + (d[2] * d[2] + d[3] * d[3]));
        const float r = post / sqrtf(ss * (1.0f / 256) + EPS);
        u32x2 w; w.x = pk2(d[0] * r * g[0], d[1] * r * g[1]); w.y = pk2(d[2] * r * g[2], d[3] * r * g[3]);
        *(u32x2*)(OA + (size_t)(MP + sm) * 1024 + hA * 256 + 4 * F.lane) = w; }
}

__device__ __forceinline__ void sample_down_in_gu(const Frame& F, unsigned* flg, const bf16* HID, const bf16* WD, float* XS) {
    const int r = 1452 % F.G, first = r, nI = F.G - first, ci = (int)blockIdx.x - first;
    if (ci < 0 || ci >= 32) return;
    if (F.tid == 0) { unsigned sp = 0; while (xb_ld(flg) < 44u) { __builtin_amdgcn_s_sleep(2); if (++sp > (1u << 24)) break; } __builtin_amdgcn_fence(__ATOMIC_ACQUIRE, "agent"); }
    __syncthreads();
    pg8::Gemm g{HID, WD, DFF}; pg8::SampleDownOrder S{nI, ci}; pg8::EpiResAdd E{0.5f, XS, (const float*)nullptr, (float*)nullptr, (bf16*)nullptr}; pg8::gemm_phase(F.lds, g, S, E);
}

constexpr int PH_PER_LAYER = 14, N_PHASES = 1 + DEPTH * PH_PER_LAYER;
__global__ void __launch_bounds__(NWAVES * 64, 2) mk_fwd(Args args) {
    extern __shared__ __attribute__((aligned(16))) unsigned char lds_[];
    Frame F; F.lds = (LAS unsigned char*)lds_;
    F.tid = threadIdx.x; F.lane = F.tid & 63; F.wave = __builtin_amdgcn_readfirstlane(F.tid >> 6); F.G = gridDim.x;
    F.gw = blockIdx.x * NWAVES + F.wave; F.NGW = F.G * NWAVES;
    F.out = args.out; F.ws = args.ws;
    volatile LAS unsigned* MISC = (volatile LAS unsigned*)(F.lds + MISC_OFF);
    if (F.tid < 32) MISC[F.tid] = 0u;
    __syncthreads();
    unsigned* ctl = (unsigned*)(F.ws + WS_CTL);
    XcdBarrier bar; bar.bar = ctl + CW_BAR; bar.x = 0; bar.st = nullptr;
    if (!MK_PER_PHASE) bar = xcd_barrier_post(ctl + CW_BAR, MISC + 8);
    const int lo = args.ph_lo, hi = args.ph_hi;
#ifndef PROBE_MASK
#define PROBE_MASK 0
#endif
#define PRB(j) ((PROBE_MASK >> (j)) & 1)
#define XBAR() do { if (!MK_PER_PHASE) xcd_barrier(bar); } while (0)
#define IN(k) (lo <= (k) && (k) < hi)
#define SEAM(k) do { if (!MK_PER_PHASE && IN(k) && IN((k) + 1)) xcd_barrier(bar); } while (0)
    if (IN(0)) { phase_prologue(F, args); }
#define OPQ(w) size_t z_ = 0; asm volatile("" : "+s"(z_)); unsigned char* w = F.ws + z_; float* xo = F.out + z_
#define LWP(w, off) ((bf16*)((w) + WS_W + (size_t)l * LW_SZ + (off)))
    for (int l = 0; l < DEPTH; ++l) {
        const int p0 = 1 + l * PH_PER_LAYER;
        if (IN(p0 + 0)) phase_rmsnorm(F, FIN(6) + l * DM, (bf16*)(F.ws + WS_H), l == 0 ? 0 : 4, l == 0 ? FIN(0) : (const float*)nullptr, l == 0 ? FIN(1) : F.out + (size_t)MP * DM);
        SEAM(p0 + 0);
        if (IN(p0 + 1)) { OPQ(w); unsigned* flg = ctl + CW_GUS + 64 * (2 * l + 0); pg8::Gemm g{(bf16*)(w + WS_H), LWP(w, LW_GU1), DM}; pg8::GuOrder S{F.G, (int)blockIdx.x, flg}; pg8::EpiSwiGLU E{(bf16*)(w + WS_HID), DFF}; pg8::gemm_phase(F.lds, g, S, E);
                           sample_down_in_gu(F, flg, (bf16*)(w + WS_HID), LWP(w, LW_D1), (float*)(w + WS_XS)); }
        SEAM(p0 + 1);
        if (IN(p0 + 2)) { OPQ(w); pg8::Gemm g{(bf16*)(w + WS_HID), LWP(w, LW_D1), DFF}; pg8::PanelOrder S; S.init(DM, DFF, F.G, (int)blockIdx.x, 0); pg8::EpiResAdd E{0.5f, (float*)(w + WS_XS), l == 0 ? FIN(0) : (const float*)nullptr, (float*)nullptr, (bf16*)(w + WS_XB)}; pg8::gemm_phase(F.lds, g, S, E); }
        SEAM(p0 + 2);
        if (IN(p0 + 3)) phase_rmsnorm(F, FIN(10) + l * DM, (bf16*)(F.ws + WS_H), 4, (const float*)nullptr, l == 0 ? FIN(1) : F.out + (size_t)MP * DM);
        SEAM(p0 + 3);
        if (IN(p0 + 4)) { OPQ(w); pg8::Gemm g{(bf16*)(w + WS_H), LWP(w, LW_IN), DM}; pg8::PanelOrder S; S.init(NIN, DM, F.G, (int)blockIdx.x, 4); pg8::EpiProj E{(bf16*)(w + WS_PROJ), (float*)(w + WS_PS), (bf16*)(w + WS_QA), (bf16*)(w + WS_KA), (bf16*)(w + WS_VA), xo, FIN(12) + l * 128, FIN(13) + l * 128, (const float2*)(w + WS_TAB), l, F.lds}; pg8::gemm_phase(F.lds, g, S, E); }
        SEAM(p0 + 4);
        if (IN(p0 + 5)) phase_rope(F, args, l);
        SEAM(p0 + 5);
        if (IN(p0 + 6)) phase_attention(F, args, l);
        SEAM(p0 + 6);
        if (IN(p0 + 7)) phase_combine(F, args, l);
        SEAM(p0 + 7);
        if (IN(p0 + 8)) { OPQ(w); pg8::Gemm g{(bf16*)(w + WS_OA), LWP(w, LW_BR), 1024}; pg8::BranchOrder S{F.G, (int)blockIdx.x}; pg8::EpiBranch E{(bf16*)(w + WS_PROJ), (bf16*)(w + WS_MRG)}; pg8::gemm_phase(F.lds, g, S, E);
                           pg8::SampleBranchOrder S2{F.G, (int)blockIdx.x}; pg8::EpiGateSlab E2{(bf16*)(w + WS_PROJ), (float*)(w + WS_XS)}; pg8::gemm_phase(F.lds, g, S2, E2); }
        SEAM(p0 + 8);
        if (IN(p0 + 9)) phase_merge_sample(F);
        SEAM(p0 + 9);
        if (IN(p0 + 10)) { OPQ(w); pg8::Gemm g{(bf16*)(w + WS_MRG), LWP(w, LW_O), DM}; pg8::PanelOrder S; S.init(DM, DM, F.G, (int)blockIdx.x, 4); pg8::EpiResAdd E{1.0f, (float*)(w + WS_XS), (const float*)nullptr, (float*)nullptr, (bf16*)(w + WS_XB)}; pg8::gemm_phase(F.lds, g, S, E); }
        SEAM(p0 + 10);
        if (IN(p0 + 11)) phase_rmsnorm(F, FIN(22) + l * DM, (bf16*)(F.ws + WS_H), 4, (const float*)nullptr, F.out + (size_t)MP * DM);
        SEAM(p0 + 11);
        if (IN(p0 + 12)) { OPQ(w); unsigned* flg = ctl + CW_GUS + 64 * (2 * l + 1); pg8::Gemm g{(bf16*)(w + WS_H), LWP(w, LW_GU2), DM}; pg8::GuOrder S{F.G, (int)blockIdx.x, flg}; pg8::EpiSwiGLU E{(bf16*)(w + WS_HID), DFF}; pg8::gemm_phase(F.lds, g, S, E);
                           sample_down_in_gu(F, flg, (bf16*)(w + WS_HID), LWP(w, LW_D2), (float*)(w + WS_XS)); }
        SEAM(p0 + 12);
        if (IN(p0 + 13)) { if (l + 1 == DEPTH) phase_final(F);
                           OPQ(w); pg8::Gemm g{(bf16*)(w + WS_HID), LWP(w, LW_D2), DFF}; pg8::PanelOrder S; S.init(DM, DFF, F.G, (int)blockIdx.x, 0); pg8::EpiResAdd E{0.5f, (float*)(w + WS_XS), (const float*)nullptr, (l + 1 == DEPTH) ? xo : (float*)nullptr, (bf16*)(w + WS_XB)}; pg8::gemm_phase(F.lds, g, S, E); }
        SEAM(p0 + 13);
    }
#undef IN
#undef SEAM
}

extern "C" void kernel_launch(void* const* d_in, const int* in_sizes, int n_in, void* d_out, int out_size, void* d_ws, size_t ws_size, hipStream_t stream) {
    static int grid = 0;
    if (grid == 0) {
        if (n_in != 26 || (size_t)out_size != O_END || ws_size < WS_END) { fprintf(stderr, "kernel_launch: shape mismatch: n_in %d out %d ws %zu (need %zu)\n", n_in, out_size, ws_size, (size_t)WS_END); grid = -1; return; }
        int dev = 0, cus = 0, per_cu = 0;
        if (hipGetDevice(&dev) != hipSuccess || hipDeviceGetAttribute(&cus, hipDeviceAttributeMultiprocessorCount, dev) != hipSuccess) { grid = -1; return; }
        if (hipFuncSetAttribute((const void*)mk_fwd, hipFuncAttributeMaxDynamicSharedMemorySize, LDS_BYTES) != hipSuccess) { fprintf(stderr, "kernel_launch: hipFuncSetAttribute failed\n"); grid = -1; return; }
        if (hipOccupancyMaxActiveBlocksPerMultiprocessor(&per_cu, (const void*)mk_fwd, NWAVES * 64, LDS_BYTES) != hipSuccess || per_cu < 1) fprintf(stderr, "kernel_launch: occupancy query says %d\n", per_cu);
        (void)hipGetLastError();
        grid = cus;
    }
    if (grid < 0) return;
    (void)in_sizes;
    if (hipMemsetAsync((char*)d_ws + WS_CTL, 0, CTL_BYTES, stream) != hipSuccess) { fprintf(stderr, "kernel_launch: memset failed\n"); return; }
    Args a{};
    for (int i = 0; i < 26; ++i) a.in[i] = (const float*)d_in[i];
    a.out = (float*)d_out; a.ws = (unsigned char*)d_ws;
#if MK_PER_PHASE
    for (int p = 0; p < N_PHASES; ++p) { a.ph_lo = p; a.ph_hi = p + 1; hipLaunchKernelGGL(mk_fwd, dim3(grid), dim3(NWAVES * 64), LDS_BYTES, stream, a); }
#else
    a.ph_lo = 0; a.ph_hi = N_PHASES;
    hipLaunchKernelGGL(mk_fwd, dim3(grid), dim3(NWAVES * 64), LDS_BYTES, stream, a);
#endif
    const hipError_t le = hipPeekAtLastError();
    if (le != hipSuccess) fprintf(stderr, "kernel_launch: launch failed: %s\n", hipGetErrorName(le));
}
```

```cpp
#include <hip/hip_runtime.h>
#include <cstdio>
#include <cstdint>

#ifndef MK_PER_PHASE
#define MK_PER_PHASE 0
#endif

constexpr int DM = 2048, SEQ = 8192, DEPTH = 2, DECB = 8, DECS = 32, PAST = 1024;
constexpr int MP = SEQ, MS = DECB * DECS, M = MP + MS;
constexpr int DFF = 5632, NIN = 10240, SKV = PAST + DECS;
constexpr int C_QA = 0, C_KA = 1024, C_VA = 2048, C_QB = 3072, C_KB = 4096, C_VB = 5120, C_GA = 6144, C_GB = 8192;
constexpr float EPS = 1e-6f, SM_SCALE = 0.088388347648318440f, LOG2E = 1.4426950408889634f;
constexpr size_t O_Y = 0, O_AKP = (size_t)M * DM, O_AVP = O_AKP + (size_t)2 * MP * 1024, O_BKP = O_AVP + (size_t)2 * MP * 1024, O_BVP = O_BKP + (size_t)2 * MP * 1024,
                 O_AKS = O_BVP + (size_t)2 * MP * 1024, O_AVS = O_AKS + (size_t)2 * MS * 1024, O_BKS = O_AVS + (size_t)2 * MS * 1024, O_BVS = O_BKS + (size_t)2 * MS * 1024,
                 O_END = O_BVS + (size_t)2 * MS * 1024;
static_assert(O_END == 86507520ull, "output size");

constexpr size_t al256(size_t x) { return (x + 255) / 256 * 256; }
constexpr size_t WS_CTL = 0, CTL_BYTES = 1u << 20;
constexpr size_t SZ_WGU = (size_t)2 * DFF * DM * 2, SZ_WD = (size_t)DM * DFF * 2, SZ_WIN = (size_t)NIN * DM * 2, SZ_WBR = (size_t)4096 * 1024 * 2, SZ_WO = (size_t)DM * DM * 2;
constexpr size_t LW_GU1 = 0, LW_D1 = LW_GU1 + SZ_WGU, LW_IN = LW_D1 + SZ_WD, LW_BR = LW_IN + SZ_WIN, LW_O = LW_BR + SZ_WBR, LW_GU2 = LW_O + SZ_WO, LW_D2 = LW_GU2 + SZ_WGU, LW_SZ = LW_D2 + SZ_WD;
constexpr size_t WS_W = CTL_BYTES;
constexpr size_t WS_H = WS_W + 2 * LW_SZ;
constexpr size_t WS_HID = WS_H + (size_t)M * DM * 2;
constexpr size_t WS_T = WS_HID;
constexpr size_t WS_PROJ = WS_HID + (size_t)M * DFF * 2;
constexpr size_t WS_QA = WS_PROJ + (size_t)M * NIN * 2;
constexpr size_t WS_KA = WS_QA + (size_t)M * 1024 * 2;
constexpr size_t WS_VA = WS_KA + (size_t)M * 1024 * 2;
constexpr size_t WS_OS = WS_VA + (size_t)M * 1024 * 2;
constexpr size_t WS_OA = WS_OS + (size_t)M * 2048 * 4;
constexpr size_t WS_OB = WS_OA + (size_t)M * 1024 * 2;
constexpr size_t WS_MRG = WS_OB + (size_t)M * 1024 * 2;
constexpr size_t WS_TAB = WS_MRG + (size_t)M * DM * 2;
constexpr size_t SZ_SKN = (size_t)MS * 1024 * 2;
constexpr size_t WS_SKN = WS_TAB + (size_t)SEQ * 64 * 8;
constexpr size_t WS_PS = WS_SKN + 8 * SZ_SKN;
constexpr size_t WS_XS = WS_PS + (size_t)4 * MS * NIN * 4;
constexpr size_t WS_XB = WS_XS + (size_t)11 * MS * DM * 4;
constexpr size_t WS_END = WS_XB + (size_t)MP * DM * 2;
static_assert((size_t)M * DM * 4 <= (size_t)M * DFF * 2, "T overlays HID");
constexpr int CW_BAR = 4096, CW_ATT = 16384, CW_GUS = 20480;

#define GAS __attribute__((address_space(1)))
#define LAS __attribute__((address_space(3)))
typedef unsigned short bf16;
typedef short bf16x8 __attribute__((ext_vector_type(8)));
typedef float f32x4 __attribute__((ext_vector_type(4)));
typedef float f32x16 __attribute__((ext_vector_type(16)));
typedef unsigned u32x4 __attribute__((ext_vector_type(4)));
typedef unsigned u32x2 __attribute__((ext_vector_type(2)));

__device__ __forceinline__ unsigned f2bf(float f) { unsigned u = __builtin_bit_cast(unsigned, f); return (u + 0x7fffu + ((u >> 16) & 1u)) >> 16; }
__device__ __forceinline__ unsigned pk2(float lo, float hi) { return f2bf(lo) | (f2bf(hi) << 16); }
__device__ __forceinline__ float bf2f(unsigned short b) { return __builtin_bit_cast(float, ((unsigned)b) << 16); }
__device__ __forceinline__ float bflo(unsigned w) { return __builtin_bit_cast(float, w << 16); }
__device__ __forceinline__ float bfhi(unsigned w) { return __builtin_bit_cast(float, w & 0xffff0000u); }
__device__ __forceinline__ unsigned cvt_pk_bf16(float lo, float hi) { unsigned r; asm volatile("v_cvt_pk_bf16_f32 %0, %1, %2" : "=v"(r) : "v"(lo), "v"(hi)); return r; }
template <int X> __device__ __forceinline__ float swz_xor(float v) { return __builtin_bit_cast(float, __builtin_amdgcn_ds_swizzle(__builtin_bit_cast(int, v), 0x1F | (X << 10))); }
__device__ __forceinline__ void half_swap(float v, float& x0, float& x1) { const unsigned a = __float_as_uint(v);
    auto rr = __builtin_amdgcn_permlane32_swap(a, a, false, false); const unsigned r0 = rr[0], r1 = rr[1]; x0 = __uint_as_float(r0); x1 = __uint_as_float(r1); }
__device__ __forceinline__ float xor32_sum(float v) { float x0, x1; half_swap(v, x0, x1); return x0 + x1; }
__device__ __forceinline__ float xor32_max(float v) { float x0, x1; half_swap(v, x0, x1); return fmaxf(x0, x1); }
__device__ __forceinline__ float wave_sum(float v) {
    v += swz_xor<1>(v); v += swz_xor<2>(v); v += swz_xor<4>(v); v += swz_xor<8>(v); v += swz_xor<16>(v);
    return xor32_sum(v);
}
__device__ __forceinline__ float sigmoidf_(float x) { return __builtin_amdgcn_rcpf(1.0f + __expf(-x)); }
__device__ __forceinline__ void st_wt(void* p, u32x4 v) { asm volatile("global_store_dwordx4 %0, %1, off sc1\n\ts_nop 1" :: "v"(p), "v"(v) : "memory"); }

__host__ __device__ __forceinline__ int qk_phys(int c) { const int d = c & 127, p = d >> 6, dd = d & 63; return (c & ~127) + 32 * (dd >> 4) + 8 * ((dd >> 2) & 3) + 4 * p + (dd & 3); }

#define XB_TMO      128
#define XB_XCNT(j)  (256  + 64 * (j))
#define XB_XSUB(j)  (1280 + 64 * (j))
#define XB_XGEN(j)  (2304 + 64 * (j))
#define XB_TOP      3328
#define XB_TOPGEN   3392
#define XCD_BAR_WORDS 3456
#define XB_SPIN_CAP (1u << 22)
__device__ __forceinline__ unsigned xb_ld(unsigned* p)              { return __hip_atomic_load(p, __ATOMIC_RELAXED, __HIP_MEMORY_SCOPE_AGENT); }
__device__ __forceinline__ unsigned xb_add(unsigned* p, unsigned v) { return __hip_atomic_fetch_add(p, v, __ATOMIC_RELAXED, __HIP_MEMORY_SCOPE_AGENT); }
__device__ __forceinline__ unsigned xb_xcc_id() { return (unsigned)__builtin_amdgcn_s_getreg((3 << 11) | 20) & 0xFu; }
#define XB_SPIN(cond, bar) do { unsigned _sp = 0; while (cond) { __builtin_amdgcn_s_sleep(1); \
    if ((++_sp & 255u) == 0u) { if (xb_ld(&(bar)[XB_TMO])) break; if (_sp > XB_SPIN_CAP) { atomicAdd(&(bar)[XB_TMO], 1u); break; } } } } while (0)
struct XcdBarrier { unsigned* bar; unsigned x; volatile LAS unsigned* st; };
__device__ __forceinline__ XcdBarrier xcd_barrier_post(unsigned* bar, volatile LAS unsigned* st) {
    XcdBarrier b; b.bar = bar; b.x = xb_xcc_id(); b.st = st;
    if (threadIdx.x == 0) (void)xb_add(&bar[XB_XCNT(b.x)], 1u);
    return b;
}
__device__ __forceinline__ void xcd_barrier_complete(unsigned* bar, unsigned x, unsigned& nloc, unsigned& nx) {
    const unsigned G = gridDim.x * gridDim.y * gridDim.z;
    unsigned sum, cnt, mine, sp = 0u;
    for (;;) {
        sum = 0u; cnt = 0u; mine = 0u;
#pragma unroll
        for (unsigned j = 0; j < 16; ++j) { const unsigned c = xb_ld(&bar[XB_XCNT(j)]); sum += c; cnt += (c > 0u) ? 1u : 0u; mine = (j == x) ? c : mine; }
        if (sum == G) break;
        __builtin_amdgcn_s_sleep(1);
        if ((++sp & 255u) == 0u) { if (xb_ld(&bar[XB_TMO])) break; if (sp > XB_SPIN_CAP) { atomicAdd(&bar[XB_TMO], 1u); break; } }
    }
    nloc = mine > 0u ? mine : 1u; nx = cnt > 0u ? cnt : 1u;
}
__device__ __forceinline__ void xcd_barrier(const XcdBarrier& b) {
    asm volatile("s_waitcnt vmcnt(0)" ::: "memory");
    __syncthreads();
    if (threadIdx.x == 0) {
        unsigned* bar = b.bar;
        __builtin_amdgcn_s_waitcnt(0);
        unsigned nloc = b.st[0], nx = b.st[1];
        if (nloc == 0u) { xcd_barrier_complete(bar, b.x, nloc, nx); b.st[0] = nloc; b.st[1] = nx; }
        const unsigned old = xb_add(&bar[XB_XSUB(b.x)], 1u);
        const unsigned gen = old / nloc;
        if (old + 1u == (gen + 1u) * nloc) {
            __builtin_amdgcn_fence(__ATOMIC_RELEASE, "agent");
            asm volatile("s_waitcnt vmcnt(0)" ::: "memory");
            const unsigned og = xb_add(&bar[XB_TOP], 1u);
            const unsigned tg = og / nx;
            if (og + 1u == (tg + 1u) * nx) xb_add(&bar[XB_TOPGEN], 1u);
            else XB_SPIN(xb_ld(&bar[XB_TOPGEN]) == tg, bar);
            __builtin_amdgcn_fence(__ATOMIC_ACQUIRE, "agent");
            xb_add(&bar[XB_XGEN(b.x)], 1u);
            asm volatile("s_waitcnt vmcnt(0)" ::: "memory");
        } else {
            XB_SPIN(xb_ld(&bar[XB_XGEN(b.x)]) == gen, bar);
            __builtin_amdgcn_fence(__ATOMIC_ACQUIRE, "agent");
            asm volatile("s_waitcnt vmcnt(0)" ::: "memory");
        }
    }
    __syncthreads();
}

namespace pg8 {
constexpr int BM = 256, BK = 64, HALF = 128, HTB = HALF * BK * 2, STAGE_BYTES = 8 * HTB, NXCD = 8, WGM = 8;
__host__ __device__ __forceinline__ int lds_byte(int r, int c) { const int st = (r >> 4) * 2 + (c >> 5), rr = r & 15, cc = c & 31, ob = rr * 64 + cc * 2; return st * 1024 + (ob ^ (((ob >> 9) & 1) << 5)); }
__host__ __device__ __forceinline__ void stage_rc(int b, int& R, int& C) { const int st = b / 1024, sb = b % 1024, swz = sb ^ (((sb >> 9) & 1) << 5); R = (st >> 1) * 16 + swz / 64; C = (st & 1) * 32 + (swz % 64) / 2; }
__host__ __device__ __forceinline__ int perm32(int rho) { const int n = rho >> 4, i = rho & 15; return 8 * (i >> 2) + 4 * n + (i & 3); }
struct Unit { int pm, pn, k0, nk, kind; };
struct Gemm { const bf16* A; const bf16* Bt; int ld; };
__device__ __forceinline__ void tile_of(int L, int nM, int nN, int& pm, int& pn) {
    const int nwg = nM * nN; int wgid = L; { const int q = nwg / NXCD, r = nwg % NXCD, xcd = wgid % NXCD, off = wgid / NXCD; wgid = (xcd < r ? xcd * (q + 1) : r * (q + 1) + (xcd - r) * q) + off; }
    const int nig = WGM * nN, gid = wgid / nig, fm = gid * WGM, gsz = (nM - fm) < WGM ? (nM - fm) : WGM;
    pm = fm + ((wgid % nig) % gsz); pn = (wgid % nig) / gsz;
}
__device__ __forceinline__ int perm40(int pn) { const int p = pn >= 20, q = pn - 20 * p, i = q >> 2, a = q & 3;
    const unsigned t = p ? (4u | 20u << 6 | 28u << 12 | 32u << 18 | 36u << 24) : (0u | 8u << 6 | 16u << 12 | 12u << 18 | 24u << 24); return (int)((t >> (6 * i)) & 63u) + a; }
struct PanelOrder {
    int nN, nP, G, c, K, sSplit, sNk;
    __device__ __forceinline__ void init(int N_, int K_, int G_, int c_, int sSplit_) { nN = N_ / BM; nP = 32 * nN; G = G_; c = c_; K = K_; sSplit = sSplit_; sNk = sSplit_ > 0 ? K_ / sSplit_ : 0; }
    __device__ __forceinline__ bool next(int i, Unit& u) const {
        const int L = i * G + c;
        if (L < nP) { tile_of(L, 32, nN, u.pm, u.pn); if (nN == 40) u.pn = perm40(u.pn); u.k0 = 0; u.nk = K; u.kind = 0; return true; }
        const int j = L - nP; if (j >= nN * sSplit) return false;
        u.pm = 32; u.pn = j / sSplit; u.k0 = (j % sSplit) * sNk; u.nk = sNk; u.kind = sSplit > 1 ? 1 : 0; return true;
    }
    __device__ __forceinline__ void a_ready(const Unit&) const {}
    __device__ __forceinline__ void done(const Unit&) const {}
};
struct GuOrder {
    int G, c; unsigned* flag;
    __device__ __forceinline__ bool next(int i, Unit& u) const {
        const int L = i * G + c; u.k0 = 0; u.nk = DM; u.kind = 0;
        if (L < 44) { u.pm = 32; u.pn = L; return true; }
        const int Lp = L < 48 ? 1404 + (L - 44) : L - 48; if (L >= 48 && Lp >= 1404) return false;
        tile_of(Lp, 32, 44, u.pm, u.pn); return true;
    }
    __device__ __forceinline__ void a_ready(const Unit&) const {}
    __device__ __forceinline__ void done(const Unit& u) const {
        if (u.pm == 32) { asm volatile("s_waitcnt vmcnt(0)" ::: "memory"); __builtin_amdgcn_s_barrier();
            if (threadIdx.x == 0) (void)xb_add(flag, 1u); }
    }
};
struct SampleDownOrder {
    int nI, ci;
    __device__ __forceinline__ bool next(int i, Unit& u) const {
        const int j = i * nI + ci; if (j >= 32) return false;
        u.pm = 32; u.pn = j >> 2; u.k0 = (j & 3) * 1408; u.nk = 1408; u.kind = 1; return true;
    }
    __device__ __forceinline__ void a_ready(const Unit&) const {}
    __device__ __forceinline__ void done(const Unit&) const {}
};
struct BranchOrder {
    int G, c;
    __device__ __forceinline__ bool next(int i, Unit& u) const {
        const int tI = (i >> 1) * G + c, which = i & 1; if (tI >= 256) return false;
        int pm, pn; tile_of(tI, 32, 8, pm, pn);
        u.pm = pm + 33 * which; u.pn = pn + 8 * which; u.k0 = 0; u.nk = 1024; u.kind = which; return true;
    }
    __device__ __forceinline__ void a_ready(const Unit&) const {}
    __device__ __forceinline__ void done(const Unit&) const {}
};
struct SampleBranchOrder {
    int G, c;
    __device__ __forceinline__ bool next(int i, Unit& u) const {
        const int j = i * G + c; if (j >= 32) return false;
        const int tile = j >> 2, which = (j >> 1) & 1, kh = j & 1;
        u.pm = 32 + 33 * which; u.pn = tile + 8 * which; u.k0 = kh * 512; u.nk = 512; u.kind = 2 * which + kh; return true;
    }
    __device__ __forceinline__ void a_ready(const Unit&) const {}
    __device__ __forceinline__ void done(const Unit&) const {}
};
template <class Epi, class Sched, bool ALIGN_EPI = true, bool SP2 = true>
__device__ __forceinline__ void gemm_phase(LAS unsigned char* lds, const Gemm g, const Sched& S, const Epi& E) {
    int tid_ = threadIdx.x; asm volatile("" : "+v"(tid_));
    const int tid = tid_, wid = __builtin_amdgcn_readfirstlane(tid >> 6), lane = tid & 63, wr = wid >> 2, wc = wid & 3, fr = lane & 15, fq = lane >> 4;
    const int K = g.ld;
    unsigned voffA[2], voffB[2];
#pragma unroll
    for (int i = 0; i < 2; ++i) { int R, C; stage_rc(tid * 16 + i * 8192, R, C); const int Rb = Epi::PERM ? ((R & ~31) + perm32(R & 31)) : R;
        voffA[i] = (unsigned)(R * K + C) * 2u; voffB[i] = (unsigned)(Rb * K + C) * 2u; }
    const size_t kstep = (size_t)(BK * 2);
    const size_t hstep = (size_t)HALF * K * 2;
    const size_t tstep = 2 * hstep;
    const unsigned ldsw = (unsigned)wid * 1024u;
    const int aoff = lds_byte(wr * 64 + fr, fq * 8), boff = lds_byte(wc * 32 + fr, fq * 8);
#define PG8_SA(b, h) (((b) * 2 + (h)) * HTB)
#define PG8_SB(b, h) ((4 + (b) * 2 + (h)) * HTB)
#define PG8_STAGE(bufoff, gbase, voff) do { _Pragma("unroll") for (int _i = 0; _i < 2; ++_i) \
        __builtin_amdgcn_global_load_lds((const unsigned*)((const char*)(gbase) + (voff)[_i]), (LAS unsigned*)(lds + (bufoff) + ldsw + _i * 8192), 16, 0, 0); } while (0)
#define PG8_LDA(dst, b, h) do { _Pragma("unroll") for (int m = 0; m < 4; ++m) _Pragma("unroll") for (int k = 0; k < 2; ++k) dst[m][k] = *(const LAS bf16x8*)(lds + PG8_SA(b, h) + aoff + m * 2048 + k * 1024); } while (0)
#define PG8_LDB(dst, b, h) do { _Pragma("unroll") for (int n = 0; n < 2; ++n) _Pragma("unroll") for (int k = 0; k < 2; ++k) dst[n][k] = *(const LAS bf16x8*)(lds + PG8_SB(b, h) + boff + n * 2048 + k * 1024); } while (0)
#define PG8_MMA(ai, bj, At, Bt) do { __builtin_amdgcn_s_setprio(1); _Pragma("unroll") for (int m = 0; m < 4; ++m) _Pragma("unroll") for (int n = 0; n < 2; ++n) _Pragma("unroll") for (int k = 0; k < 2; ++k) \
        acc[ai][bj][m][n] = __builtin_amdgcn_mfma_f32_16x16x32_bf16(Bt[n][k], At[m][k], acc[ai][bj][m][n], 0, 0, 0); __builtin_amdgcn_s_setprio(0); } while (0)
#define PG8_WAIT_V(n) asm volatile("s_waitcnt vmcnt(" #n ")" ::: "memory")
#define PG8_WAIT_L(n) asm volatile("s_waitcnt lgkmcnt(" #n ")" ::: "memory")
#define PG8_BAR __builtin_amdgcn_s_barrier()
#define PG8_SCHED __builtin_amdgcn_sched_barrier(0)
    Unit cur, nxt; int ui = 0;
    if (!S.next(0, cur)) return;
    f32x4 acc[2][2][4][2];
#pragma unroll
    for (int a = 0; a < 2; ++a)
#pragma unroll
        for (int b = 0; b < 2; ++b)
#pragma unroll
            for (int m = 0; m < 4; ++m)
#pragma unroll
                for (int n = 0; n < 2; ++n) acc[a][b][m][n] = (f32x4){0.f, 0.f, 0.f, 0.f};
    bf16x8 At[4][2], B0[2][2], B1[2][2];
    const char* cA = (const char*)g.A + (size_t)cur.pm * tstep + (size_t)cur.k0 * 2; const char* cB = (const char*)g.Bt + (size_t)cur.pn * tstep + (size_t)cur.k0 * 2;
    S.a_ready(cur);
    PG8_STAGE(PG8_SB(0, 0), cB, voffB); PG8_STAGE(PG8_SB(0, 1), cB + hstep, voffB); PG8_STAGE(PG8_SA(0, 0), cA, voffA); PG8_STAGE(PG8_SA(0, 1), cA + hstep, voffA);
    if (wr == 1) PG8_BAR;
    PG8_WAIT_V(2); PG8_BAR;
    PG8_STAGE(PG8_SB(1, 0), cB + kstep, voffB); PG8_STAGE(PG8_SA(1, 0), cA + kstep, voffA); PG8_STAGE(PG8_SB(1, 1), cB + hstep + kstep, voffB);
    PG8_WAIT_V(6); PG8_BAR;
    bool has_next; const char* nA; const char* nB;
#define PG8_NEXT() do { has_next = S.next(ui + 1, nxt); \
        nA = has_next ? (const char*)g.A + (size_t)nxt.pm * tstep + (size_t)nxt.k0 * 2 : cA; nB = has_next ? (const char*)g.Bt + (size_t)nxt.pn * tstep + (size_t)nxt.k0 * 2 : cB; } while (0)
#define PG8_KLOOP() do { const int nt = cur.nk / BK; \
        for (int t = 0; t < nt; t += 2) { \
            const bool last = (t == nt - 2); \
            const char* a1 = cA + (size_t)(t + 1) * kstep; \
            const char* a2 = last ? nA : cA + (size_t)(t + 2) * kstep; const char* b2 = last ? nB : cB + (size_t)(t + 2) * kstep; \
            const char* a3 = a2 + kstep; const char* b3 = b2 + kstep; \
            if (last && has_next) S.a_ready(nxt); \
            PG8_LDB(B0, 0, 0); PG8_LDB(B1, 0, 1); PG8_SCHED; PG8_LDA(At, 0, 0); PG8_STAGE(PG8_SA(1, 1), a1 + hstep, voffA); \
            PG8_WAIT_V(8); PG8_WAIT_L(0); PG8_BAR; PG8_MMA(0, 0, At, B0); PG8_MMA(0, 1, At, B1); PG8_BAR; PG8_SCHED; \
            PG8_LDA(At, 0, 1); PG8_STAGE(PG8_SB(0, 0), b2, voffB); PG8_STAGE(PG8_SB(0, 1), b2 + hstep, voffB); PG8_STAGE(PG8_SA(0, 0), a2, voffA); \
            PG8_WAIT_V(8); PG8_WAIT_L(0); PG8_BAR; PG8_MMA(1, 0, At, B0); PG8_MMA(1, 1, At, B1); PG8_BAR; PG8_SCHED; \
            PG8_LDB(B0, 1, 0); PG8_LDB(B1, 1, 1); PG8_SCHED; PG8_LDA(At, 1, 0); PG8_STAGE(PG8_SA(0, 1), a2 + hstep, voffA); \
            PG8_WAIT_V(8); PG8_WAIT_L(0); PG8_BAR; PG8_MMA(0, 0, At, B0); PG8_MMA(0, 1, At, B1); PG8_BAR; PG8_SCHED; \
            PG8_LDA(At, 1, 1); PG8_STAGE(PG8_SB(1, 0), b3, voffB); PG8_STAGE(PG8_SB(1, 1), b3 + hstep, voffB); PG8_STAGE(PG8_SA(1, 0), a3, voffA); \
            PG8_WAIT_V(8); PG8_WAIT_L(0); PG8_BAR; PG8_MMA(1, 0, At, B0); PG8_MMA(1, 1, At, B1); PG8_BAR; PG8_SCHED; \
        } } while (0)
    static_assert(SP2, "only the two-super-phase K-loop is kept");
    for (;;) {
        PG8_NEXT();
        PG8_KLOOP();
        if constexpr (Epi::PAIRED) {
            E.mid(acc, cur, wr, wc, fr, fq);
            cur = nxt; cA = nA; cB = nB; ++ui;
            PG8_NEXT();
            PG8_KLOOP();
        }
        if constexpr (ALIGN_EPI) { if (wr == 0) PG8_BAR; }
        E(acc, cur, wr, wc, fr, fq); S.done(cur);
        if (!has_next) break;
#pragma unroll
        for (int a = 0; a < 2; ++a)
#pragma unroll
            for (int b = 0; b < 2; ++b)
#pragma unroll
                for (int m = 0; m < 4; ++m)
#pragma unroll
                    for (int n = 0; n < 2; ++n) acc[a][b][m][n] = (f32x4){0.f, 0.f, 0.f, 0.f};
        cur = nxt; cA = nA; cB = nB; ++ui;
        if constexpr (ALIGN_EPI) { if (wr == 1) PG8_BAR; }
    }
    PG8_WAIT_V(0);
    if constexpr (!ALIGN_EPI) { if (wr == 0) PG8_BAR; }
    PG8_BAR;
#undef PG8_NEXT
#undef PG8_KLOOP
#undef PG8_SA
#undef PG8_SB
#undef PG8_STAGE
#undef PG8_LDA
#undef PG8_LDB
#undef PG8_MMA
#undef PG8_WAIT_V
#undef PG8_WAIT_L
#undef PG8_BAR
#undef PG8_SCHED
}

constexpr int XCH_OFF = 135168;
struct EpiProj {
    static constexpr bool PERM = true, PAIRED = false;
    bf16* O; float* PS; bf16* QA; bf16* KA; bf16* VA; float* out; const float* gq; const float* gk; const float2* tab; int l; LAS unsigned char* lds;
    __device__ __forceinline__ void operator()(const f32x4 (&acc)[2][2][4][2], const Unit& u, int wr, int wc, int fr_, int fq_) const {
        int fr = fr_, fq = fq_; asm volatile("" : "+v"(fr), "+v"(fq));
        const int col0 = u.pn * BM + wc * 32 + 8 * fq;
        if (u.kind != 0) { const int row0 = wr * 64 + fr; float* slab = PS + (size_t)(u.k0 / u.nk) * MS * NIN;
#pragma unroll
            for (int ai = 0; ai < 2; ++ai)
#pragma unroll
                for (int m = 0; m < 4; ++m) { float* rowp = slab + (size_t)(row0 + ai * HALF + m * 16) * NIN + col0;
#pragma unroll
                    for (int bj = 0; bj < 2; ++bj) { *(f32x4*)(rowp + bj * HALF) = acc[ai][bj][m][0]; *(f32x4*)(rowp + bj * HALF + 4) = acc[ai][bj][m][1]; } }
            return; }
        const int row0 = u.pm * BM + wr * 64 + fr;
        if (u.pn < 8) {
            const bool isk = u.pn >= 4; const float* gg = isk ? gk : gq; const int dd0 = 16 * wc + 4 * fq;
            const f32x4 g1 = *(const f32x4*)(gg + dd0), g2 = *(const f32x4*)(gg + 64 + dd0);
            LAS float* xch = (LAS float*)(lds + XCH_OFF);
            f32x4 cst[2][4][2];
#pragma unroll
            for (int ai = 0; ai < 2; ++ai)
#pragma unroll
                for (int m = 0; m < 4; ++m) { const size_t row = (size_t)(row0 + ai * HALF + m * 16); cst[ai][m][0] = *(const f32x4*)(tab + row * 64 + dd0); cst[ai][m][1] = *(const f32x4*)(tab + row * 64 + dd0 + 2); }
#pragma unroll
            for (int ai = 0; ai < 2; ++ai)
#pragma unroll
                for (int m = 0; m < 4; ++m) { const int rl = ai * HALF + wr * 64 + m * 16 + fr;
#pragma unroll
                    for (int bj = 0; bj < 2; ++bj) { const f32x4 a = acc[ai][bj][m][0], b = acc[ai][bj][m][1];
                        float s = (a[0] * a[0] + a[1] * a[1]) + (a[2] * a[2] + a[3] * a[3]) + (b[0] * b[0] + b[1] * b[1]) + (b[2] * b[2] + b[3] * b[3]);
                        s += swz_xor<16>(s); s = xor32_sum(s);
                        if (fq == 0) xch[(rl * 2 + bj) * 4 + wc] = s; } }
            asm volatile("s_waitcnt lgkmcnt(0)" ::: "memory"); __builtin_amdgcn_s_barrier(); asm volatile("" ::: "memory");
            bf16* dq = isk ? KA : QA; float* oak = out + O_AKP + (size_t)l * MP * 1024;
#pragma unroll
            for (int ai = 0; ai < 2; ++ai)
#pragma unroll
                for (int m = 0; m < 4; ++m) { const int rl = ai * HALF + wr * 64 + m * 16 + fr; const size_t row = (size_t)(row0 + ai * HALF + m * 16);
                    const f32x4 c01 = cst[ai][m][0], c23 = cst[ai][m][1];
                    const float cs[4] = {c01[0], c01[2], c23[0], c23[2]}, sn[4] = {c01[1], c01[3], c23[1], c23[3]};
#pragma unroll
                    for (int bj = 0; bj < 2; ++bj) { const f32x4 t = *(const LAS f32x4*)(xch + (rl * 2 + bj) * 4);
                        const float r = 1.0f / sqrtf(((t[0] + t[1]) + (t[2] + t[3])) * (1.0f / 128) + EPS);
                        f32x4 o1, o2;
#pragma unroll
                        for (int e = 0; e < 4; ++e) { const float y1 = acc[ai][bj][m][0][e] * r * g1[e], y2 = acc[ai][bj][m][1][e] * r * g2[e]; o1[e] = y1 * cs[e] - y2 * sn[e]; o2[e] = y2 * cs[e] + y1 * sn[e]; }
                        const int hc = (2 * (u.pn & 3) + bj) * 128 + dd0;
                        u32x2 w; w.x = cvt_pk_bf16(o1[0], o1[1]); w.y = cvt_pk_bf16(o1[2], o1[3]); *(u32x2*)(dq + row * 1024 + hc) = w;
                        w.x = cvt_pk_bf16(o2[0], o2[1]); w.y = cvt_pk_bf16(o2[2], o2[3]); *(u32x2*)(dq + row * 1024 + hc + 64) = w;
                        if (isk) { *(f32x4*)(oak + row * 1024 + hc) = o1; *(f32x4*)(oak + row * 1024 + hc + 64) = o2; } } }
        } else {
            const int t4 = u.pn >> 2;
            float* fo = (t4 == 2) ? out + O_AVP + (size_t)l * MP * 1024 - C_VA : (t4 == 4) ? out + O_BKP + (size_t)l * MP * 1024 - C_KB : (t4 == 5) ? out + O_BVP + (size_t)l * MP * 1024 - C_VB : nullptr;
#pragma unroll
            for (int ai = 0; ai < 2; ++ai)
#pragma unroll
                for (int m = 0; m < 4; ++m) { const size_t row = (size_t)(row0 + ai * HALF + m * 16); bf16* rowp = (t4 == 2) ? VA + row * 1024 + (col0 - C_VA) : O + row * NIN + col0;
#pragma unroll
                    for (int bj = 0; bj < 2; ++bj) { const f32x4 v0 = acc[ai][bj][m][0], v1 = acc[ai][bj][m][1];
                        u32x4 w; w.x = cvt_pk_bf16(v0[0], v0[1]); w.y = cvt_pk_bf16(v0[2], v0[3]); w.z = cvt_pk_bf16(v1[0], v1[1]); w.w = cvt_pk_bf16(v1[2], v1[3]);
                        *(u32x4*)(rowp + bj * HALF) = w;
                        if (fo) { float* fp = fo + row * 1024 + col0 + bj * HALF; *(f32x4*)fp = v0; *(f32x4*)(fp + 4) = v1; } } }
        }
    }
};
struct EpiSwiGLU {
    static constexpr bool PERM = true, PAIRED = false;
    bf16* O; int ldc;
    __device__ __forceinline__ void operator()(const f32x4 (&acc)[2][2][4][2], const Unit& u, int wr, int wc, int fr_, int fq_) const {
        int fr = fr_, fq = fq_; asm volatile("" : "+v"(fr), "+v"(fq));
        const int row0 = u.pm * BM + wr * 64 + fr, col0 = u.pn * HALF + wc * 32 + 8 * fq;
#pragma unroll
        for (int ai = 0; ai < 2; ++ai)
#pragma unroll
            for (int m = 0; m < 4; ++m) { bf16* rowp = O + (size_t)(row0 + ai * HALF + m * 16) * ldc + col0;
                float r[8];
#pragma unroll
                for (int n = 0; n < 2; ++n) { const f32x4 G = acc[ai][0][m][n], U = acc[ai][1][m][n]; f32x4 E, R;
#pragma unroll
                    for (int e = 0; e < 4; ++e) E[e] = __builtin_amdgcn_exp2f(-G[e]);
                    const f32x4 D = E + 1.0f;
#pragma unroll
                    for (int e = 0; e < 4; ++e) R[e] = __builtin_amdgcn_rcpf(D[e]);
                    const f32x4 O = (G * U) * R;
#pragma unroll
                    for (int e = 0; e < 4; ++e) r[n * 4 + e] = O[e]; }
                u32x4 w; w.x = cvt_pk_bf16(r[0], r[1]); w.y = cvt_pk_bf16(r[2], r[3]); w.z = cvt_pk_bf16(r[4], r[5]); w.w = cvt_pk_bf16(r[6], r[7]);
                if (u.pm == 32) st_wt(rowp, w); else *(u32x4*)rowp = w; }
    }
};
struct EpiResAdd {
    static constexpr bool PERM = true, PAIRED = false;
    float f; float* XS; const float* Xin; float* Xout; bf16* XB;
    __device__ __forceinline__ void operator()(const f32x4 (&acc)[2][2][4][2], const Unit& u, int wr, int wc, int fr_, int fq_) const {
        int fr = fr_, fq = fq_; asm volatile("" : "+v"(fr), "+v"(fq));
        const int row0 = u.pm * BM + wr * 64 + fr, col0 = u.pn * BM + wc * 32 + 8 * fq;
        if (u.kind == 0) {
#pragma unroll
            for (int ai = 0; ai < 2; ++ai) {
                f32x4 xv[4][2][2];
                if (Xin) {
#pragma unroll
                    for (int m = 0; m < 4; ++m)
#pragma unroll
                        for (int bj = 0; bj < 2; ++bj) { const float* p = Xin + (size_t)(row0 + ai * HALF + m * 16) * DM + col0 + bj * HALF; xv[m][bj][0] = *(const f32x4*)p; xv[m][bj][1] = *(const f32x4*)(p + 4); }
                } else {
#pragma unroll
                    for (int m = 0; m < 4; ++m)
#pragma unroll
                        for (int bj = 0; bj < 2; ++bj) { const u32x4 w = *(const u32x4*)(XB + (size_t)(row0 + ai * HALF + m * 16) * DM + col0 + bj * HALF);
                            xv[m][bj][0] = (f32x4){bflo(w.x), bfhi(w.x), bflo(w.y), bfhi(w.y)}; xv[m][bj][1] = (f32x4){bflo(w.z), bfhi(w.z), bflo(w.w), bfhi(w.w)}; }
                }
#pragma unroll
                for (int m = 0; m < 4; ++m) { const size_t ro = (size_t)(row0 + ai * HALF + m * 16) * DM + col0;
#pragma unroll
                    for (int bj = 0; bj < 2; ++bj) { const f32x4 v0 = xv[m][bj][0] + acc[ai][bj][m][0] * f, v1 = xv[m][bj][1] + acc[ai][bj][m][1] * f;
                        if (Xout) { *(f32x4*)(Xout + ro + bj * HALF) = v0; *(f32x4*)(Xout + ro + bj * HALF + 4) = v1; }
                        else { u32x4 w; w.x = cvt_pk_bf16(v0[0], v0[1]); w.y = cvt_pk_bf16(v0[2], v0[3]); w.z = cvt_pk_bf16(v1[0], v1[1]); w.w = cvt_pk_bf16(v1[2], v1[3]); *(u32x4*)(XB + ro + bj * HALF) = w; } } }
                asm volatile("" ::: "memory"); }
        } else { float* slab = XS + (size_t)(u.k0 / u.nk) * MS * DM;
#pragma unroll
            for (int ai = 0; ai < 2; ++ai)
#pragma unroll
                for (int m = 0; m < 4; ++m) { float* rowp = slab + (size_t)(wr * 64 + fr + ai * HALF + m * 16) * DM + col0;
#pragma unroll
                    for (int bj = 0; bj < 2; ++bj) { *(f32x4*)(rowp + bj * HALF) = acc[ai][bj][m][0] * f; *(f32x4*)(rowp + bj * HALF + 4) = acc[ai][bj][m][1] * f; } }
        }
    }
};
struct EpiBranch {
    static constexpr bool PERM = true, PAIRED = true;
    const bf16* G; bf16* O;
    __device__ __forceinline__ void mid(f32x4 (&acc)[2][2][4][2], const Unit& u, int wr, int wc, int fr_, int fq_) const {
        int fr = fr_, fq = fq_; asm volatile("" : "+v"(fr), "+v"(fq));
        const int row0 = u.pm * BM + wr * 64 + fr, col0 = u.pn * BM + wc * 32 + 8 * fq;
#pragma unroll
        for (int ai = 0; ai < 2; ++ai) {
            u32x4 gav[4][2], gbv[4][2];
#pragma unroll
            for (int m = 0; m < 4; ++m)
#pragma unroll
                for (int bj = 0; bj < 2; ++bj) { const size_t ro = (size_t)(row0 + ai * HALF + m * 16) * NIN + col0 + bj * HALF; gav[m][bj] = *(const u32x4*)(G + ro + C_GA); gbv[m][bj] = *(const u32x4*)(G + ro + C_GB); }
#pragma unroll
            for (int m = 0; m < 4; ++m)
#pragma unroll
                for (int bj = 0; bj < 2; ++bj) { const unsigned gaw[4] = {gav[m][bj].x, gav[m][bj].y, gav[m][bj].z, gav[m][bj].w}, gbw[4] = {gbv[m][bj].x, gbv[m][bj].y, gbv[m][bj].z, gbv[m][bj].w};
#pragma unroll
                    for (int q = 0; q < 4; ++q) { const float a0 = bflo(gaw[q]), a1 = bfhi(gaw[q]), b0 = fmaxf(bflo(gbw[q]), -30.f), b1 = fmaxf(bfhi(gbw[q]), -30.f);
                        const float r0 = (1.0f + __expf(-b0)) * __builtin_amdgcn_rcpf(1.0f + __expf(-a0)), r1 = (1.0f + __expf(-b1)) * __builtin_amdgcn_rcpf(1.0f + __expf(-a1));
                        acc[ai][bj][m][q >> 1][(q & 1) * 2] *= r0; acc[ai][bj][m][q >> 1][(q & 1) * 2 + 1] *= r1; } }
#pragma unroll
            for (int m = 0; m < 4; ++m) asm volatile("" : "+v"(acc[ai][0][m][0]), "+v"(acc[ai][0][m][1]), "+v"(acc[ai][1][m][0]), "+v"(acc[ai][1][m][1]));
            asm volatile("" ::: "memory"); }
    }
    __device__ __forceinline__ void operator()(const f32x4 (&acc)[2][2][4][2], const Unit& u, int wr, int wc, int fr_, int fq_) const {
        int fr = fr_, fq = fq_; asm volatile("" : "+v"(fr), "+v"(fq));
        const int row0 = (u.pm - 33) * BM + wr * 64 + fr, col0 = (u.pn - 8) * BM + wc * 32 + 8 * fq;
#pragma unroll
        for (int ai = 0; ai < 2; ++ai) {
            u32x4 gbv[4][2];
#pragma unroll
            for (int m = 0; m < 4; ++m)
#pragma unroll
                for (int bj = 0; bj < 2; ++bj) gbv[m][bj] = *(const u32x4*)(G + (size_t)(row0 + ai * HALF + m * 16) * NIN + C_GB + col0 + bj * HALF);
#pragma unroll
            for (int m = 0; m < 4; ++m) { const size_t row = (size_t)(row0 + ai * HALF + m * 16);
#pragma unroll
                for (int bj = 0; bj < 2; ++bj) { const int c = col0 + bj * HALF; const unsigned gbw[4] = {gbv[m][bj].x, gbv[m][bj].y, gbv[m][bj].z, gbv[m][bj].w}; float r[8];
#pragma unroll
                    for (int q = 0; q < 4; ++q) { r[2 * q] = acc[ai][bj][m][q >> 1][(q & 1) * 2] * sigmoidf_(fmaxf(bflo(gbw[q]), -30.f)); r[2 * q + 1] = acc[ai][bj][m][q >> 1][(q & 1) * 2 + 1] * sigmoidf_(fmaxf(bfhi(gbw[q]), -30.f)); }
                    u32x4 w; w.x = cvt_pk_bf16(r[0], r[1]); w.y = cvt_pk_bf16(r[2], r[3]); w.z = cvt_pk_bf16(r[4], r[5]); w.w = cvt_pk_bf16(r[6], r[7]);
                    *(u32x4*)(O + row * DM + c) = w; } }
            asm volatile("" ::: "memory"); }
    }
};
struct EpiGateSlab {
    static constexpr bool PERM = true, PAIRED = false;
    const bf16* G; float* SL;
    __device__ __forceinline__ void operator()(const f32x4 (&acc)[2][2][4][2], const Unit& u, int wr, int wc, int fr_, int fq_) const {
        int fr = fr_, fq = fq_; asm volatile("" : "+v"(fr), "+v"(fq));
        const int which = u.kind >> 1, row0 = wr * 64 + fr, col0 = (u.pn - 8 * which) * BM + wc * 32 + 8 * fq, gc = which ? C_GB : C_GA;
        float* slab = SL + (size_t)u.kind * MS * DM;
#pragma unroll
        for (int ai = 0; ai < 2; ++ai) {
            u32x4 gv[4][2];
#pragma unroll
            for (int m = 0; m < 4; ++m)
#pragma unroll
                for (int bj = 0; bj < 2; ++bj) gv[m][bj] = *(const u32x4*)(G + (size_t)(MP + row0 + ai * HALF + m * 16) * NIN + gc + col0 + bj * HALF);
#pragma unroll
            for (int m = 0; m < 4; ++m) { float* rowp = slab + (size_t)(row0 + ai * HALF + m * 16) * DM + col0;
#pragma unroll
                for (int bj = 0; bj < 2; ++bj) { const unsigned gw[4] = {gv[m][bj].x, gv[m][bj].y, gv[m][bj].z, gv[m][bj].w}; f32x4 o0, o1;
                    o0[0] = acc[ai][bj][m][0][0] * sigmoidf_(bflo(gw[0])); o0[1] = acc[ai][bj][m][0][1] * sigmoidf_(bfhi(gw[0])); o0[2] = acc[ai][bj][m][0][2] * sigmoidf_(bflo(gw[1])); o0[3] = acc[ai][bj][m][0][3] * sigmoidf_(bfhi(gw[1]));
                    o1[0] = acc[ai][bj][m][1][0] * sigmoidf_(bflo(gw[2])); o1[1] = acc[ai][bj][m][1][1] * sigmoidf_(bfhi(gw[2])); o1[2] = acc[ai][bj][m][1][2] * sigmoidf_(bflo(gw[3])); o1[3] = acc[ai][bj][m][1][3] * sigmoidf_(bfhi(gw[3]));
                    *(f32x4*)(rowp + bj * HALF) = o0; *(f32x4*)(rowp + bj * HALF + 4) = o1; } }
            asm volatile("" ::: "memory"); }
    }
};
}

constexpr int NWAVES = 8;
constexpr int RING_BYTES = 131072, MISC_OFF = RING_BYTES + 320, LDS_BYTES = 147456;
struct Args { const float* in[26]; float* out; unsigned char* ws; int ph_lo, ph_hi; };
struct Frame {
    LAS unsigned char* lds; int tid, lane, wave, G, gw, NGW;
    float* out; unsigned char* ws;
};
#define FIN(i) (args.in[i])
#define OPAQUE_FRAME(F) Frame F = F0; { int t_ = threadIdx.x; asm volatile("" : "+v"(t_)); F.tid = t_; F.lane = t_ & 63; { size_t z_ = 0; asm volatile("" : "+s"(z_), "+s"(F.gw)); F.ws = F0.ws + z_; F.out = F0.out + z_; } }

__device__ __forceinline__ void transpose_item(const float* W, int K, int N, bf16* WT, int mode, int row_off, LAS float* scr, int item, int lane) {
    const int nblk = N / 32, kb = item / nblk, nb = item % nblk, k0 = 64 * kb, n0 = 32 * nb;
    const float wsc = (mode == 1) ? LOG2E : (mode == 2) ? 0.6931471805599453f : 1.0f;
#pragma unroll 8
    for (int i = 0; i < 32; ++i) { const int kk = 2 * i + (lane >> 5); scr[kk * 33 + (lane & 31)] = W[(size_t)(k0 + kk) * N + n0 + (lane & 31)]; }
    asm volatile("s_waitcnt lgkmcnt(0)" ::: "memory");
    const int rb = (mode == 0 || mode == 3) ? (row_off + n0) : (256 * (n0 >> 7) + (n0 & 127) + (mode == 2 ? 128 : 0));
    const int c = lane & 7;
#pragma unroll
    for (int j = 0; j < 4; ++j) { const int n = (lane >> 3) + 8 * j; const LAS float* s = scr + (8 * c) * 33 + n;
        u32x4 o; o.x = pk2(s[0 * 33] * wsc, s[1 * 33] * wsc); o.y = pk2(s[2 * 33] * wsc, s[3 * 33] * wsc); o.z = pk2(s[4 * 33] * wsc, s[5 * 33] * wsc); o.w = pk2(s[6 * 33] * wsc, s[7 * 33] * wsc);
        const int drow = (mode == 3 && rb < 2048) ? qk_phys(rb + n) : rb + n;
        *(u32x4*)(WT + (size_t)drow * K + k0 + 8 * c) = o; }
    asm volatile("s_waitcnt lgkmcnt(0)" ::: "memory");
}
__device__ __forceinline__ void transpose_matrix(Frame& F, const float* W, int K, int N, bf16* WT, int mode, int row_off) {
    LAS float* scr = (LAS float*)(F.lds + F.wave * 16384);
    const int nitems = (K / 64) * (N / 32);
    for (int it = F.gw; it < nitems; it += F.NGW) transpose_item(W, K, N, WT, mode, row_off, scr, it, F.lane);
}
__device__ __forceinline__ bf16* lw(Frame& F, int l, size_t off) { return (bf16*)(F.ws + WS_W + (size_t)l * LW_SZ + off); }
__device__ __forceinline__ bf16* skn(Frame& F, int l, int t) { return (bf16*)(F.ws + WS_SKN + (size_t)(l * 4 + t) * SZ_SKN); }

__device__ __forceinline__ void phase_prologue(const Frame& F0, const Args& args) {
    OPAQUE_FRAME(F);
    for (int l = 0; l < DEPTH; ++l) {
        transpose_matrix(F, FIN(7) + (size_t)l * DM * DFF, DM, DFF, lw(F, l, LW_GU1), 1, 0);
        transpose_matrix(F, FIN(8) + (size_t)l * DM * DFF, DM, DFF, lw(F, l, LW_GU1), 2, 0);
        transpose_matrix(F, FIN(9) + (size_t)l * DFF * DM, DFF, DM, lw(F, l, LW_D1), 0, 0);
        transpose_matrix(F, FIN(11) + (size_t)l * DM * NIN, DM, NIN, lw(F, l, LW_IN), 3, 0);
        transpose_matrix(F, FIN(19) + (size_t)l * 1024 * DM, 1024, DM, lw(F, l, LW_BR), 0, 0);
        transpose_matrix(F, FIN(20) + (size_t)l * 1024 * DM, 1024, DM, lw(F, l, LW_BR), 0, 2048);
        transpose_matrix(F, FIN(21) + (size_t)l * DM * DM, DM, DM, lw(F, l, LW_O), 0, 0);
        transpose_matrix(F, FIN(23) + (size_t)l * DM * DFF, DM, DFF, lw(F, l, LW_GU2), 1, 0);
        transpose_matrix(F, FIN(24) + (size_t)l * DM * DFF, DM, DFF, lw(F, l, LW_GU2), 2, 0);
        transpose_matrix(F, FIN(25) + (size_t)l * DFF * DM, DFF, DM, lw(F, l, LW_D2), 0, 0);
    }
    { float2* tab = (float2*)(F.ws + WS_TAB); const size_t gt = (size_t)blockIdx.x * 512 + F.tid, NT = (size_t)F.G * 512;
      for (size_t i = gt; i < (size_t)SEQ * 64; i += NT) { const int pos = (int)(i >> 6), dd = (int)(i & 63);
          double inv = 1.0; for (int k = 0; k < dd; ++k) inv *= 0.8659643233600653;
          const double ang = (double)pos * inv;
          const double kq = __builtin_rint(ang * 0.6366197723675814);
          double r = ang - kq * 1.5707963267948966; r -= kq * 6.123233995736766e-17;
          const double r2 = r * r;
          double s = r * (1.0 + r2 * (-1.0 / 6 + r2 * (1.0 / 120 + r2 * (-1.0 / 5040 + r2 * (1.0 / 362880 + r2 * (-1.0 / 39916800 + r2 * (1.0 / 6227020800.0)))))));
          double c = 1.0 + r2 * (-0.5 + r2 * (1.0 / 24 + r2 * (-1.0 / 720 + r2 * (1.0 / 40320 + r2 * (-1.0 / 3628800 + r2 * (1.0 / 479001600.0 + r2 * (-1.0 / 87178291200.0)))))));
          const int q = ((int)kq) & 3; double cs, sn;
          if (q == 0) { cs = c; sn = s; } else if (q == 1) { cs = -s; sn = c; } else if (q == 2) { cs = -c; sn = -s; } else { cs = s; sn = -c; }
          tab[i] = make_float2((float)cs, (float)sn); } }
}

__device__ __forceinline__ void rms_load_row(f32x4 (&v)[8], int m, int lane, int nslab, const float* xp, const float* xs, const bf16* XB, const float* XS, float* out) {
    if (m < MP && xp == nullptr) { const bf16* xb = XB + (size_t)m * DM;
#pragma unroll
        for (int j = 0; j < 8; ++j) { const u32x2 w = *(const u32x2*)(xb + 4 * lane + 256 * j); v[j] = (f32x4){bflo(w.x), bfhi(w.x), bflo(w.y), bfhi(w.y)}; }
    } else { const float* xr = (m < MP) ? xp + (size_t)m * DM : xs + (size_t)(m - MP) * DM;
#pragma unroll
        for (int j = 0; j < 8; ++j) v[j] = *(const f32x4*)(xr + 4 * lane + 256 * j); }
    if (m >= MP && nslab > 0) { float* xw = out + (size_t)m * DM;
        int s = 0;
#pragma unroll 1
        for (; s + 4 <= nslab; s += 4) { const float* sl = XS + ((size_t)s * MS + (m - MP)) * DM; f32x4 t[4][8];
#pragma unroll
            for (int q = 0; q < 4; ++q)
#pragma unroll
                for (int j = 0; j < 8; ++j) t[q][j] = *(const f32x4*)(sl + (size_t)q * MS * DM + 4 * lane + 256 * j);
#pragma unroll
            for (int j = 0; j < 8; ++j) v[j] += (t[0][j] + t[1][j]) + (t[2][j] + t[3][j]); }
#pragma unroll 1
        for (; s < nslab; ++s) { const float* sl = XS + ((size_t)s * MS + (m - MP)) * DM;
#pragma unroll
            for (int j = 0; j < 8; ++j) v[j] += *(const f32x4*)(sl + 4 * lane + 256 * j); }
#pragma unroll
        for (int j = 0; j < 8; ++j) *(f32x4*)(xw + 4 * lane + 256 * j) = v[j];
    }
}
__device__ __forceinline__ void rms_store_row(const f32x4 (&v)[8], const f32x4 (&g)[8], int m, int lane, bf16* H) {
    float ss = 0.f;
#pragma unroll
    for (int j = 0; j < 8; ++j) ss += (v[j][0] * v[j][0] + v[j][1] * v[j][1]) + (v[j][2] * v[j][2] + v[j][3] * v[j][3]);
    const float r = 1.0f / sqrtf(wave_sum(ss) * (1.0f / DM) + EPS);
    bf16* hr = H + (size_t)m * DM;
#pragma unroll
    for (int j = 0; j < 8; ++j) { u32x2 w; w.x = pk2(v[j][0] * r * g[j][0], v[j][1] * r * g[j][1]); w.y = pk2(v[j][2] * r * g[j][2], v[j][3] * r * g[j][3]); *(u32x2*)(hr + 4 * lane + 256 * j) = w; }
}
__device__ __forceinline__ void phase_rmsnorm(const Frame& F0, const float* gain, bf16* H, int nslab, const float* xp, const float* xs) {
    OPAQUE_FRAME(F);
    const float* XS = (const float*)(F.ws + WS_XS); const bf16* XB = (const bf16*)(F.ws + WS_XB);
    f32x4 g[8];
#pragma unroll
    for (int j = 0; j < 8; ++j) g[j] = *(const f32x4*)(gain + 4 * F.lane + 256 * j);
    for (int m0 = F.gw; m0 < M; m0 += 2 * F.NGW) {
        const int m1 = m0 + F.NGW; f32x4 va[8], vb[8];
        rms_load_row(va, m0, F.lane, nslab, xp, xs, XB, XS, F.out);
        if (m1 < M) rms_load_row(vb, m1, F.lane, nslab, xp, xs, XB, XS, F.out);
        rms_store_row(va, g, m0, F.lane, H);
        if (m1 < M) rms_store_row(vb, g, m1, F.lane, H);
    }
}
__device__ __forceinline__ void phase_merge_sample(const Frame& F0) {
    OPAQUE_FRAME(F);
    const float* SL = (const float*)(F.ws + WS_XS); bf16* MRG = (bf16*)(F.ws + WS_MRG);
    for (int sm = F.gw; sm < MS; sm += F.NGW) {
#pragma unroll
        for (int j = 0; j < 8; ++j) { const size_t o = (size_t)sm * DM + 4 * F.lane + 256 * j;
            const f32x4 v = (*(const f32x4*)(SL + o) + *(const f32x4*)(SL + (size_t)MS * DM + o)) + (*(const f32x4*)(SL + (size_t)2 * MS * DM + o) + *(const f32x4*)(SL + (size_t)3 * MS * DM + o));
            u32x2 w; w.x = pk2(v[0], v[1]); w.y = pk2(v[2], v[3]); *(u32x2*)(MRG + (size_t)(MP + sm) * DM + 4 * F.lane + 256 * j) = w; }
    }
}
__device__ __forceinline__ void phase_final(const Frame& F0) {
    OPAQUE_FRAME(F);
    const float* XS = (const float*)(F.ws + WS_XS);
    for (int task = F.gw; task < MS * 8; task += F.NGW) {
        const int sm = task >> 3, j = task & 7; float* xr = F.out + (size_t)(MP + sm) * DM + 4 * F.lane + 256 * j; const float* sl = XS + (size_t)sm * DM + 4 * F.lane + 256 * j;
        f32x4 v = *(const f32x4*)xr, t[4];
#pragma unroll
        for (int s = 0; s < 4; ++s) t[s] = *(const f32x4*)(sl + (size_t)s * MS * DM);
#pragma unroll
        for (int s = 0; s < 4; ++s) v += t[s];
        *(f32x4*)xr = v;
    }
}
__device__ __forceinline__ void phase_rope(const Frame& F0, const Args& args, int l) {
    OPAQUE_FRAME(F);
    bf16* proj = (bf16*)(F.ws + WS_PROJ); bf16* QA = (bf16*)(F.ws + WS_QA); const float* PS = (const float*)(F.ws + WS_PS);
    const float2* tab = (const float2*)(F.ws + WS_TAB);
    const float gq1 = FIN(12)[l * 128 + F.lane], gq2 = FIN(12)[l * 128 + 64 + F.lane], gk1 = FIN(13)[l * 128 + F.lane], gk2 = FIN(13)[l * 128 + 64 + F.lane];
    for (int task = F.gw; task < MS * 8; task += F.NGW) {
        const int sm = task >> 3, part = task & 7;
        const int m = MP + sm, tt = sm & 31, pos = PAST + tt;
        bf16* pr = proj + (size_t)m * NIN; const float* ps = PS + (size_t)sm * NIN;
#define PSUM(c) (ps[(c)] + ps[(size_t)MS * NIN + (c)] + ps[(size_t)2 * MS * NIN + (c)] + ps[(size_t)3 * MS * NIN + (c)])
#define PSUM4(c) (*(const f32x4*)(ps + (c)) + *(const f32x4*)(ps + (size_t)MS * NIN + (c)) + *(const f32x4*)(ps + (size_t)2 * MS * NIN + (c)) + *(const f32x4*)(ps + (size_t)3 * MS * NIN + (c)))
        float* oak = F.out + O_AKS + ((size_t)l * MS + sm) * 1024; float* oav = F.out + O_AVS + ((size_t)l * MS + sm) * 1024;
        float* obk = F.out + O_BKS + ((size_t)l * MS + sm) * 1024; float* obv = F.out + O_BVS + ((size_t)l * MS + sm) * 1024;
        const size_t srow = (size_t)sm * 1024;
        if (part < 4) { const float2 cs = tab[pos * 64 + F.lane];
#pragma unroll
            for (int h2 = 0; h2 < 2; ++h2) { const int hh = 2 * part + h2;
                { const float x1 = PSUM(qk_phys(C_QA + hh * 128 + F.lane)), x2 = PSUM(qk_phys(C_QA + hh * 128 + 64 + F.lane));
                  const float r = 1.0f / sqrtf(wave_sum(x1 * x1 + x2 * x2) * (1.0f / 128) + EPS); const float y1 = x1 * r * gq1, y2 = x2 * r * gq2;
                  QA[(size_t)m * 1024 + hh * 128 + F.lane] = (bf16)f2bf(y1 * cs.x - y2 * cs.y); QA[(size_t)m * 1024 + hh * 128 + 64 + F.lane] = (bf16)f2bf(y2 * cs.x + y1 * cs.y); }
                { const float x1 = PSUM(qk_phys(C_KA + hh * 128 + F.lane)), x2 = PSUM(qk_phys(C_KA + hh * 128 + 64 + F.lane));
                  const float r = 1.0f / sqrtf(wave_sum(x1 * x1 + x2 * x2) * (1.0f / 128) + EPS); const float y1 = x1 * r * gk1, y2 = x2 * r * gk2;
                  const float o1 = y1 * cs.x - y2 * cs.y, o2 = y2 * cs.x + y1 * cs.y;
                  oak[hh * 128 + F.lane] = o1; oak[hh * 128 + 64 + F.lane] = o2;
                  bf16* d = skn(F, l, 0) + srow; d[hh * 128 + F.lane] = (bf16)f2bf(o1); d[hh * 128 + 64 + F.lane] = (bf16)f2bf(o2); } }
        } else if (part == 4) {
#pragma unroll
            for (int j = 0; j < 4; ++j) { const int c = 4 * F.lane + 256 * j; const f32x4 va = PSUM4(C_VA + c), kb = PSUM4(C_KB + c);
                *(f32x4*)(oav + c) = va; *(f32x4*)(obk + c) = kb;
                u32x2 w; w.x = pk2(va[0], va[1]); w.y = pk2(va[2], va[3]); *(u32x2*)(skn(F, l, 1) + srow + c) = w;
                w.x = pk2(kb[0], kb[1]); w.y = pk2(kb[2], kb[3]); *(u32x2*)(skn(F, l, 2) + srow + c) = w; }
        } else if (part == 5) {
#pragma unroll
            for (int j = 0; j < 4; ++j) { const int c = 4 * F.lane + 256 * j; const f32x4 vb = PSUM4(C_VB + c), qb = PSUM4(C_QB + c);
                *(f32x4*)(obv + c) = vb;
                u32x2 w; w.x = pk2(vb[0], vb[1]); w.y = pk2(vb[2], vb[3]); *(u32x2*)(skn(F, l, 3) + srow + c) = w;
                w.x = pk2(qb[0], qb[1]); w.y = pk2(qb[2], qb[3]); *(u32x2*)(pr + C_QB + c) = w; }
        } else {
#pragma unroll
            for (int j = 0; j < 8; ++j) { const int c = C_GA + 4 * F.lane + 256 * (j + 8 * (part - 6)); const f32x4 g = PSUM4(c);
                u32x2 w; w.x = pk2(g[0], g[1]); w.y = pk2(g[2], g[3]); *(u32x2*)(pr + c) = w; }
        }
#undef PSUM
#undef PSUM4
    }
}

__device__ __forceinline__ bf16x8 ld8(const bf16* p) { return *(const bf16x8*)p; }
__device__ __forceinline__ bf16x8 ldcol8(const bf16* p, size_t ld) { bf16x8 v;
#pragma unroll
    for (int j = 0; j < 8; ++j) v[j] = (short)p[(size_t)j * ld];
    return v; }
#define PK4(P, BASE, OUT) do { unsigned a0 = cvt_pk_bf16(P[BASE + 0], P[BASE + 1]), a1 = cvt_pk_bf16(P[BASE + 2], P[BASE + 3]);   \
    unsigned b0 = cvt_pk_bf16(P[BASE + 4], P[BASE + 5]), b1 = cvt_pk_bf16(P[BASE + 6], P[BASE + 7]);                              \
    auto r0 = __builtin_amdgcn_permlane32_swap(a0, b0, false, false); auto r1 = __builtin_amdgcn_permlane32_swap(a1, b1, false, false); \
    u32x4 w_ = {r0[0], r1[0], r0[1], r1[1]}; OUT = *reinterpret_cast<bf16x8*>(&w_); } while (0)
__device__ __forceinline__ int crow(int r, int hi) { return (r & 3) + 8 * (r >> 2) + 4 * hi; }
template <bool MASKED> __device__ __forceinline__ void stick32(f32x16& p, int kpos0, int qpos, int hi, float& carry) {
    constexpr float C = SM_SCALE * LOG2E;
    float Gs[4], Gp[4], Gt[4];
#pragma unroll
    for (int g = 0; g < 4; ++g) { float kp[4], be[4];
#pragma unroll
        for (int i = 0; i < 4; ++i) { const float u = __builtin_amdgcn_exp2f(fminf(p[4 * g + i] * C, 115.f)); const float k = __builtin_amdgcn_rcpf(1.0f + u);
            const bool v = !MASKED || (kpos0 + 8 * g + 4 * hi + i < qpos); kp[i] = v ? k : 1.f; be[i] = v ? u * k : 0.f; }
        const float w2 = kp[3], w1 = w2 * kp[2], w0 = w1 * kp[1]; Gs[g] = w0 * kp[0];
        p[4 * g + 3] = be[3]; p[4 * g + 2] = be[2] * w2; p[4 * g + 1] = be[1] * w1; p[4 * g] = be[0] * w0; }
#pragma unroll
    for (int g = 0; g < 4; ++g) { float x0, x1; half_swap(Gs[g], x0, x1); Gp[g] = hi ? x0 : x1; Gt[g] = x0 * x1; }
    float T[4]; float run = 1.f;
#pragma unroll
    for (int g = 3; g >= 0; --g) { T[g] = carry * run * (hi == 0 ? Gp[g] : 1.f); run *= Gt[g]; }
#pragma unroll
    for (int i = 0; i < 16; ++i) p[i] *= T[i >> 2];
    carry *= run;
}

__device__ __forceinline__ bf16x8 ld8f_o(const float* base, unsigned off) { const f32x4 a = *(const f32x4*)((const char*)base + off), b = *(const f32x4*)((const char*)base + off + 16u);
    u32x4 w = {cvt_pk_bf16(a[0], a[1]), cvt_pk_bf16(a[2], a[3]), cvt_pk_bf16(b[0], b[1]), cvt_pk_bf16(b[2], b[3])}; return *reinterpret_cast<bf16x8*>(&w); }
__device__ __forceinline__ bf16x8 ld8_o(const bf16* base, unsigned off) { return *(const bf16x8*)((const char*)base + off); }
__device__ __forceinline__ bf16x8 ldcol8f_o(const float* base, unsigned off) { float v[8];
#pragma unroll
    for (int j = 0; j < 8; ++j) v[j] = *(const float*)((const char*)base + off + (unsigned)j * 4096u);
    u32x4 w = {cvt_pk_bf16(v[0], v[1]), cvt_pk_bf16(v[2], v[3]), cvt_pk_bf16(v[4], v[5]), cvt_pk_bf16(v[6], v[7])}; return *reinterpret_cast<bf16x8*>(&w); }
__device__ __forceinline__ bf16x8 ldcol8_o(const bf16* base, unsigned off) { bf16x8 v;
#pragma unroll
    for (int j = 0; j < 8; ++j) v[j] = (short)*(const bf16*)((const char*)base + off + (unsigned)j * 2048u);
    return v; }
struct SampleKV { const float* Kc; const float* Vc; const bf16* Kn; const bf16* Vn; };
__device__ __forceinline__ void sample_scores(f32x16& p, const SampleKV& kv, int t, const bf16x8 (&qf)[8], int r, int h) {
#pragma unroll
    for (int i = 0; i < 16; ++i) p[i] = 0.f;
    if (t < 32) { unsigned off = (unsigned)((32 * t + r) * 1024 + 8 * h) * 4u; asm volatile("" : "+v"(off));
#pragma unroll
        for (int s = 0; s < 8; ++s) { p = __builtin_amdgcn_mfma_f32_32x32x16_bf16(ld8f_o(kv.Kc, off + 64u * s), qf[s], p, 0, 0, 0); }
    } else { unsigned off = (unsigned)(r * 1024 + 8 * h) * 2u; asm volatile("" : "+v"(off));
#pragma unroll
        for (int s = 0; s < 8; ++s) p = __builtin_amdgcn_mfma_f32_32x32x16_bf16(ld8_o(kv.Kn, off + 32u * s), qf[s], p, 0, 0, 0); }
}
__device__ __forceinline__ void sample_pv(f32x16 (&o)[4], const SampleKV& kv, int t, bf16x8 pa0, bf16x8 pa1, int r, int h) {
    if (t < 32) { unsigned off = (unsigned)((32 * t + 8 * h) * 1024 + r) * 4u; asm volatile("" : "+v"(off));
#pragma unroll
        for (int d = 0; d < 4; ++d) { const bf16x8 v0 = ldcol8f_o(kv.Vc, off + 128u * d), v1 = ldcol8f_o(kv.Vc, off + 128u * d + 16u * 4096u);
            o[d] = __builtin_amdgcn_mfma_f32_32x32x16_bf16(v0, pa0, o[d], 0, 0, 0); o[d] = __builtin_amdgcn_mfma_f32_32x32x16_bf16(v1, pa1, o[d], 0, 0, 0);
            }
    } else { unsigned off = (unsigned)((8 * h) * 1024 + r) * 2u; asm volatile("" : "+v"(off));
#pragma unroll
        for (int d = 0; d < 4; ++d) { const bf16x8 v0 = ldcol8_o(kv.Vn, off + 64u * d), v1 = ldcol8_o(kv.Vn, off + 64u * d + 16u * 2048u);
            o[d] = __builtin_amdgcn_mfma_f32_32x32x16_bf16(v0, pa0, o[d], 0, 0, 0); o[d] = __builtin_amdgcn_mfma_f32_32x32x16_bf16(v1, pa1, o[d], 0, 0, 0); } }
}
__device__ __forceinline__ void sample_v_dma(const SampleKV& kv, int t, LAS unsigned char* vbuf, int lane) {
    asm volatile("" ::: "memory");
    if (t < 32) { unsigned off = (unsigned)((32 * t + (lane >> 5)) * 1024 + 4 * (lane & 31)) * 4u; asm volatile("" : "+v"(off));
#pragma unroll
        for (int i = 0; i < 16; ++i) __builtin_amdgcn_global_load_lds((const unsigned*)((const char*)kv.Vc + off + (unsigned)i * 8192u), (LAS unsigned*)(vbuf + i * 1024), 16, 0, 0); }
    asm volatile("" ::: "memory");
}
__device__ __forceinline__ void sample_pv_any(f32x16 (&o)[4], const SampleKV& kv, int t, const LAS unsigned char* vbuf, bf16x8 pa0, bf16x8 pa1, int r, int h) {
    if (t < 32) {
        asm volatile("s_waitcnt vmcnt(0)" ::: "memory");
        const LAS float* vb = (const LAS float*)(vbuf + (8 * h) * 512 + r * 4);
#pragma unroll
        for (int d = 0; d < 4; ++d) { float a[8], b[8];
#pragma unroll
            for (int j = 0; j < 8; ++j) { a[j] = vb[j * 128 + d * 32]; b[j] = vb[(16 + j) * 128 + d * 32]; }
            u32x4 w0 = {cvt_pk_bf16(a[0], a[1]), cvt_pk_bf16(a[2], a[3]), cvt_pk_bf16(a[4], a[5]), cvt_pk_bf16(a[6], a[7])}, w1 = {cvt_pk_bf16(b[0], b[1]), cvt_pk_bf16(b[2], b[3]), cvt_pk_bf16(b[4], b[5]), cvt_pk_bf16(b[6], b[7])};
            o[d] = __builtin_amdgcn_mfma_f32_32x32x16_bf16(*reinterpret_cast<bf16x8*>(&w0), pa0, o[d], 0, 0, 0); o[d] = __builtin_amdgcn_mfma_f32_32x32x16_bf16(*reinterpret_cast<bf16x8*>(&w1), pa1, o[d], 0, 0, 0); }
        asm volatile("" ::: "memory");
    } else sample_pv(o, kv, t, pa0, pa1, r, h);
}
__device__ __forceinline__ void soft_range(const bf16* Q, int ldq, const SampleKV& kv, int t0, int t1, f32x16 (&o)[4], float& m_run, float& l_run, int lane, LAS unsigned char* vbuf) {
    const int r = lane & 31, h = lane >> 5;
    bf16x8 qf[8];
#pragma unroll
    for (int s = 0; s < 8; ++s) qf[s] = ld8(Q + (size_t)r * ldq + 16 * s + 8 * h);
#pragma unroll
    for (int d = 0; d < 4; ++d)
#pragma unroll
        for (int i = 0; i < 16; ++i) o[d][i] = 0.f;
    m_run = -1e30f; l_run = 0.f; const float C = SM_SCALE * LOG2E;
    for (int t = t0; t < t1; ++t) {
        sample_v_dma(kv, t, vbuf, lane);
        f32x16 p; sample_scores(p, kv, t, qf, r, h);
        float mx = p[0];
#pragma unroll
        for (int i = 1; i < 16; ++i) mx = fmaxf(mx, p[i]);
        mx = xor32_max(mx);
        const float mn = fmaxf(m_run, mx), alpha = __builtin_amdgcn_exp2f((m_run - mn) * C), mc = mn * C; m_run = mn;
        float sum = 0.f;
#pragma unroll
        for (int i = 0; i < 16; ++i) { p[i] = __builtin_amdgcn_exp2f(p[i] * C - mc); sum += p[i]; }
        sum = xor32_sum(sum);
        l_run = l_run * alpha + sum;
#pragma unroll
        for (int d = 0; d < 4; ++d)
#pragma unroll
            for (int i = 0; i < 16; ++i) o[d][i] *= alpha;
        bf16x8 pa0, pa1; PK4(p, 0, pa0); PK4(p, 8, pa1);
        sample_pv_any(o, kv, t, vbuf, pa0, pa1, r, h);
    }
}
__device__ __forceinline__ float stick_tile(const bf16x8 (&qf)[8], const SampleKV& kv, int t, f32x16 (&o)[4], int lane, LAS unsigned char* vbuf) {
    const int r = lane & 31, h = lane >> 5;
#pragma unroll
    for (int d = 0; d < 4; ++d)
#pragma unroll
        for (int i = 0; i < 16; ++i) o[d][i] = 0.f;
    float carry = 1.f;
    sample_v_dma(kv, t, vbuf, lane);
    f32x16 p; sample_scores(p, kv, t, qf, r, h);
    if (t == 32) stick32<true>(p, 0, r, h, carry); else stick32<false>(p, 0, r, h, carry);
    bf16x8 pa0, pa1; PK4(p, 0, pa0); PK4(p, 8, pa1);
    sample_pv_any(o, kv, t, vbuf, pa0, pa1, r, h);
    return carry;
}
constexpr int SML_OFF = 132096;
__device__ __forceinline__ void sampleA_item(const bf16* Q, SampleKV kv, int QQ, float* OP, float* ML, LAS unsigned char* lds, int tid_) {
    int tid = tid_; asm volatile("" : "+v"(tid));
    const int wid = __builtin_amdgcn_readfirstlane(tid >> 6), lane = tid & 63, r = lane & 31, h = lane >> 5, kq = wid & 3, vh = wid >> 2;
    LAS float* ml = (LAS float*)(lds + SML_OFF);
    kv.Vc += vh * 128; kv.Vn += vh * 128;
    { f32x16 o[4]; float m_run, l_run;
      const int tb = QQ == 0 ? 0 : 1 + 8 * QQ, tl = QQ == 0 ? 9 : 8;
      soft_range(Q, 1024, kv, tb + (kq * tl) / 4, tb + ((kq + 1) * tl) / 4, o, m_run, l_run, lane, lds + wid * 16384);
      LAS float* po = (LAS float*)(lds + wid * 16384);
#pragma unroll
      for (int d = 0; d < 4; ++d)
#pragma unroll
          for (int i = 0; i < 16; ++i) po[(d * 16 + i) * 64 + lane] = o[d][i];
      if (h == 0) { ml[wid * 64 + r] = m_run; ml[wid * 64 + 32 + r] = l_run; } }
    __syncthreads();
    { const float C = SM_SCALE * LOG2E; const int vh2 = tid >> 8, t8 = tid & 255, ln = t8 & 63, q = ln & 31, hh = ln >> 5, sub = t8 >> 6;
      float f[4], M_ = -1e30f, lt = 0.f;
#pragma unroll
      for (int j = 0; j < 4; ++j) M_ = fmaxf(M_, ml[(vh2 * 4 + j) * 64 + q]);
#pragma unroll
      for (int j = 0; j < 4; ++j) { f[j] = __builtin_amdgcn_exp2f((ml[(vh2 * 4 + j) * 64 + q] - M_) * C); lt += ml[(vh2 * 4 + j) * 64 + 32 + q] * f[j]; }
      if (tid < 32) { ML[q * 64] = M_; ML[q * 64 + 1] = lt; }
#pragma unroll 4
      for (int k = 0; k < 16; ++k) { const int di = k * 4 + sub, d = di >> 4, i = di & 15; float acc = 0.f;
#pragma unroll
          for (int j = 0; j < 4; ++j) acc += ((const LAS float*)(lds + (vh2 * 4 + j) * 16384))[di * 64 + ln] * f[j];
          OP[(size_t)q * 8192 + vh2 * 128 + 32 * d + (i & 3) + 8 * (i >> 2) + 4 * hh] = acc; } }
    __syncthreads();
}
__device__ __forceinline__ void sampleB_item(const bf16* Q, SampleKV kv, bf16* O, LAS unsigned char* lds, int tid_) {
    int tid = tid_; asm volatile("" : "+v"(tid));
    const int wid = __builtin_amdgcn_readfirstlane(tid >> 6), lane = tid & 63, r = lane & 31, h = lane >> 5;
    LAS float* ltot = (LAS float*)(lds + SML_OFF);
    const int q = lane & 31, hh = lane >> 5, sub = wid;
    bf16x8 qf[8];
#pragma unroll
    for (int s = 0; s < 8; ++s) qf[s] = ld8(Q + (size_t)r * NIN + 16 * s + 8 * h);
    float outv[8], Cprev = 1.f;
#pragma unroll
    for (int k = 0; k < 8; ++k) outv[k] = 0.f;
#pragma unroll 1
    for (int st = 0; st < 5; ++st) {
        const int t = (st < 4) ? 25 - 8 * st + wid : (wid == 0 ? 0 : -1);
        { f32x16 o[4]; float lt = 1.f;
          if (t >= 0) lt = stick_tile(qf, kv, t, o, lane, lds + wid * 16384);
          else {
#pragma unroll
              for (int d = 0; d < 4; ++d)
#pragma unroll
                  for (int i = 0; i < 16; ++i) o[d][i] = 0.f; }
          LAS float* po = (LAS float*)(lds + wid * 16384);
#pragma unroll
          for (int d = 0; d < 4; ++d)
#pragma unroll
              for (int i = 0; i < 16; ++i) po[(d * 16 + i) * 64 + lane] = o[d][i];
          if (h == 0) ltot[wid * 32 + r] = lt; }
        __syncthreads();
        float f[8]; float run = Cprev;
#pragma unroll
        for (int j = 7; j >= 0; --j) { f[j] = run; run *= ltot[j * 32 + q]; }
        Cprev = run;
#pragma unroll 2
        for (int k = 0; k < 8; ++k) { const int di = k * 8 + sub; float acc = 0.f;
#pragma unroll
            for (int j = 0; j < 8; ++j) acc += ((const LAS float*)(lds + j * 16384))[di * 64 + lane] * f[j];
            outv[k] += acc; }
        const bool done = __all(Cprev < 1e-30f);
        __syncthreads();
        if (done) break;
    }
#pragma unroll
    for (int k = 0; k < 8; ++k) { const int di = k * 8 + sub, d = di >> 4, i = di & 15;
        O[(size_t)q * 1024 + 32 * d + (i & 3) + 8 * (i >> 2) + 4 * hh] = (bf16)f2bf(outv[k]); }
}

namespace att {
#define KSWZ(row, colB) ((row) * 256 + ((colB) ^ (((row) & 7) << 4)))
#define SBAR() __builtin_amdgcn_sched_barrier(0)
typedef short s16x4 __attribute__((ext_vector_type(4)));
constexpr float THR = 8.f;
__device__ __forceinline__ void partialSM(f32x16& p0, f32x16& p1, float& m_reg, float& mn, float& alpha) {
    constexpr float C = SM_SCALE * LOG2E;
    float tm[16];
#pragma unroll
    for (int r = 0; r < 16; ++r) tm[r] = fmaxf(p0[r], p1[r]);
#pragma unroll
    for (int s = 8; s > 0; s >>= 1)
#pragma unroll
        for (int r = 0; r < s; ++r) tm[r] = fmaxf(tm[r], tm[r + s]);
    float pmax = xor32_max(tm[0]);
    if (__builtin_expect(__all(pmax - m_reg <= THR / SM_SCALE), 1)) { mn = m_reg; alpha = 1.f; }
    else { mn = fmaxf(m_reg, pmax); alpha = __builtin_amdgcn_exp2f((m_reg - mn) * C); m_reg = mn; }
    const float mnC = -mn * C;
#pragma unroll
    for (int r = 0; r < 16; ++r) p0[r] = fmaf(p0[r], C, mnC);
#pragma unroll
    for (int r = 0; r < 16; ++r) p1[r] = fmaf(p1[r], C, mnC);
#pragma unroll
    for (int r = 0; r < 16; ++r) p0[r] = __builtin_amdgcn_exp2f(p0[r]);
}
__device__ __forceinline__ void finishSM_noexp(f32x16& p0, f32x16& p1, float& l_reg, bf16x8& pa0, bf16x8& pa1, bf16x8& pa2, bf16x8& pa3) {
    float ts[16];
#pragma unroll
    for (int r = 0; r < 16; ++r) ts[r] = p0[r] + p1[r];
#pragma unroll
    for (int s = 8; s > 0; s >>= 1)
#pragma unroll
        for (int r = 0; r < s; ++r) ts[r] += ts[r + s];
    l_reg += xor32_sum(ts[0]);
    PK4(p0, 0, pa0); PK4(p0, 8, pa1); PK4(p1, 0, pa2); PK4(p1, 8, pa3);
}
__device__ __forceinline__ void finishSM(f32x16& p0, f32x16& p1, float alpha, float& l_reg, bf16x8& pa0, bf16x8& pa1, bf16x8& pa2, bf16x8& pa3) {
#pragma unroll
    for (int r = 0; r < 16; ++r) p1[r] = __builtin_amdgcn_exp2f(p1[r]);
    float ts[16];
#pragma unroll
    for (int r = 0; r < 16; ++r) ts[r] = p0[r] + p1[r];
#pragma unroll
    for (int s = 8; s > 0; s >>= 1)
#pragma unroll
        for (int r = 0; r < s; ++r) ts[r] += ts[r + s];
    float ps = xor32_sum(ts[0]);
    l_reg = l_reg * alpha + ps;
    PK4(p0, 0, pa0); PK4(p0, 8, pa1); PK4(p1, 0, pa2); PK4(p1, 8, pa3);
}
template <int KB> __device__ __forceinline__ void qkt(f32x16& p0, f32x16& p1, const LAS char* K_lds, const bf16x8 (&qr)[8], int r32, int hi) {
#pragma unroll
    for (int i = 0; i < 16; ++i) { p0[i] = 0.f; p1[i] = 0.f; }
    const LAS char* kb[4];
#pragma unroll
    for (int dd = 0; dd < 4; ++dd) kb[dd] = K_lds + KSWZ(r32, (dd * 16 + hi * 8) * 2);
#pragma unroll
    for (int d0 = 0; d0 < 8; ++d0) { const LAS char* a = kb[d0 & 3] + (d0 >> 2) * 128 + KB * 16384;
        const bf16x8 b0 = *(const LAS bf16x8*)a;
        const bf16x8 b1 = *(const LAS bf16x8*)(a + 32 * 256);
        p0 = __builtin_amdgcn_mfma_f32_32x32x16_bf16(b0, qr[d0], p0, 0, 0, 0);
        p1 = __builtin_amdgcn_mfma_f32_32x32x16_bf16(b1, qr[d0], p1, 0, 0, 0); }
}
__device__ __forceinline__ int v_st(int k, int c) { const int kk = (k & ~0xC) | ((k & 4) << 1) | ((k & 8) >> 1); return ((kk >> 3) * 4 + (c >> 5)) * 512 + ((kk & 7) * 32 + (c & 31)) * 2; }
__device__ __forceinline__ int v_rd_base(int lane) { return ((lane & 3) << 3) | (((lane >> 2) & 3) << 6) | (((lane >> 4) & 1) << 5) | (((lane >> 5) & 1) << 8); }
constexpr int v_rd_off(int vbuf, int d0, int ks, int half) { return vbuf * 32768 + d0 * 512 + ks * 4096 + half * 2048; }
template <int OFF> __device__ __forceinline__ s16x4 tr_read(int vb) { s16x4 r; asm volatile("ds_read_b64_tr_b16 %0, %1 offset:%2" : "=&v"(r) : "v"(vb), "i"(OFF) : "memory"); return r; }
template <int VB, int D0> __device__ __forceinline__ void pv_one(f32x16& od, int vb, bf16x8 pa0, bf16x8 pa1, bf16x8 pa2, bf16x8 pa3) {
    const s16x4 l0 = tr_read<v_rd_off(VB, D0, 0, 0)>(vb), h0 = tr_read<v_rd_off(VB, D0, 0, 1)>(vb), l1 = tr_read<v_rd_off(VB, D0, 1, 0)>(vb), h1 = tr_read<v_rd_off(VB, D0, 1, 1)>(vb);
    const s16x4 l2 = tr_read<v_rd_off(VB, D0, 2, 0)>(vb), h2 = tr_read<v_rd_off(VB, D0, 2, 1)>(vb), l3 = tr_read<v_rd_off(VB, D0, 3, 0)>(vb), h3 = tr_read<v_rd_off(VB, D0, 3, 1)>(vb);
    asm volatile("s_waitcnt lgkmcnt(0)" ::: "memory"); SBAR();
#define PKV(L, H) (bf16x8){L[0], L[1], L[2], L[3], H[0], H[1], H[2], H[3]}
    od = __builtin_amdgcn_mfma_f32_32x32x16_bf16(pa0, PKV(l0, h0), od, 0, 0, 0);
    od = __builtin_amdgcn_mfma_f32_32x32x16_bf16(pa1, PKV(l1, h1), od, 0, 0, 0);
    od = __builtin_amdgcn_mfma_f32_32x32x16_bf16(pa2, PKV(l2, h2), od, 0, 0, 0);
    od = __builtin_amdgcn_mfma_f32_32x32x16_bf16(pa3, PKV(l3, h3), od, 0, 0, 0);
#undef PKV
}
template <int VB> __device__ __forceinline__ void pv_d0(f32x16 (&o)[4], int vb, bf16x8 pa0, bf16x8 pa1, bf16x8 pa2, bf16x8 pa3) {
    pv_one<VB, 0>(o[0], vb, pa0, pa1, pa2, pa3); pv_one<VB, 1>(o[1], vb, pa0, pa1, pa2, pa3); pv_one<VB, 2>(o[2], vb, pa0, pa1, pa2, pa3); pv_one<VB, 3>(o[3], vb, pa0, pa1, pa2, pa3);
}
__device__ __forceinline__ void attnA_body(const bf16* __restrict__ Qb, const bf16* __restrict__ Kh, const bf16* __restrict__ Vh, float* __restrict__ Ob, int NT, LAS char* lds, int tid_) {
    int tid = tid_; asm volatile("" : "+v"(tid));
    const int wid = __builtin_amdgcn_readfirstlane(tid >> 6), lane = tid & 63, r32 = lane & 31, hi = lane >> 5, wq = wid & 3, vh = wid >> 2;
    const bool skip_last = wq < 2;
    LAS char* V_lds = lds; LAS char* K_lds = lds + 65536;
    LAS float* wsp = (LAS float*)(lds + 98304) + wid * 64; LAS float* li_l = wsp; LAS float* al_l = wsp + 32;
    float m_reg = -1e30f, l_reg = 0.f; f32x16 o[4]; bf16x8 qr[8];
#pragma unroll
    for (int d = 0; d < 4; ++d)
#pragma unroll
        for (int i = 0; i < 16; ++i) o[d][i] = 0.f;
    const bf16* Qw = Qb + (size_t)(wq * 32 + r32) * 1024 + hi * 8;
#pragma unroll
    for (int d0 = 0; d0 < 8; ++d0) qr[d0] = ld8(Qw + d0 * 16);
    const int sr = tid >> 4, sc = (tid & 15) * 8, vst0 = v_st(sr, sc), vst1 = v_st(32 + sr, sc);
    const int vb0 = (int)(uintptr_t)(V_lds + vh * 16384) + v_rd_base(lane);
    bf16x8 ks0, ks1, v00, v01, v10, v11;
    const unsigned kof = (unsigned)(sr * 1024 + sc) * 2u, vof = kof;
#define LDG(base, off) (*(const bf16x8*)((const char*)(base) + (off)))
#define SLOAD(k0) do { const unsigned kk_ = kof + (unsigned)(k0) * 2048u, vv_ = vof + (unsigned)(k0) * 2048u; ks0 = LDG(Kh, kk_); ks1 = LDG(Kh, kk_ + 32u * 2048u); \
    v00 = LDG(Vh, vv_); v01 = LDG(Vh, vv_ + 256u); v10 = LDG(Vh, vv_ + 32u * 2048u); v11 = LDG(Vh, vv_ + 32u * 2048u + 256u); } while (0)
#define SWRITE(b) do { *(LAS bf16x8*)(V_lds + (b) * 32768 + vst0) = v00; *(LAS bf16x8*)(V_lds + (b) * 32768 + 16384 + vst0) = v01; *(LAS bf16x8*)(V_lds + (b) * 32768 + vst1) = v10; *(LAS bf16x8*)(V_lds + (b) * 32768 + 16384 + vst1) = v11; \
    *(LAS bf16x8*)(K_lds + (b) * 16384 + KSWZ(sr, sc * 2)) = ks0; *(LAS bf16x8*)(K_lds + (b) * 16384 + KSWZ(32 + sr, sc * 2)) = ks1; } while (0)
#define SWAIT() asm volatile("s_waitcnt vmcnt(0)" ::: "memory")
#define RESC(a) do { if (__any((a) < 1.f)) { if (hi == 0) al_l[r32] = (a); asm volatile("s_waitcnt lgkmcnt(0)" ::: "memory"); \
    _Pragma("unroll") for (int d = 0; d < 4; ++d) _Pragma("unroll") for (int r = 0; r < 16; ++r) o[d][r] *= al_l[crow(r, hi)]; } } while (0)
    f32x16 pA0, pA1, pB0, pB1; float mnA, mnB, alA, alB; bf16x8 pa0, pa1, pa2, pa3;
    SLOAD(0); SWAIT(); SWRITE(0); __syncthreads();
    qkt<0>(pA0, pA1, K_lds, qr, r32, hi); partialSM(pA0, pA1, m_reg, mnA, alA);
    SLOAD(64); SWAIT(); SWRITE(1); __syncthreads();
    for (int j = 1; j + 1 < NT; j += 2) {
        SBAR(); SLOAD((j + 1) * 64); SBAR();
        qkt<1>(pB0, pB1, K_lds, qr, r32, hi);
        finishSM(pA0, pA1, alA, l_reg, pa0, pa1, pa2, pa3); SBAR();
        pv_d0<0>(o, vb0, pa0, pa1, pa2, pa3); partialSM(pB0, pB1, m_reg, mnB, alB);
        __syncthreads(); SWAIT(); SWRITE(0);
        RESC(alB); __syncthreads();
        SBAR(); SLOAD((j + 2) * 64); SBAR();
        qkt<0>(pA0, pA1, K_lds, qr, r32, hi);
        finishSM(pB0, pB1, alB, l_reg, pa0, pa1, pa2, pa3); SBAR();
        pv_d0<1>(o, vb0, pa0, pa1, pa2, pa3); partialSM(pA0, pA1, m_reg, mnA, alA);
        __syncthreads(); SWAIT(); SWRITE(1);
        RESC(alA); __syncthreads();
    }
    SBAR(); if (!skip_last) qkt<1>(pB0, pB1, K_lds, qr, r32, hi);
    finishSM(pA0, pA1, alA, l_reg, pa0, pa1, pa2, pa3); SBAR();
    pv_d0<0>(o, vb0, pa0, pa1, pa2, pa3);
    if (!skip_last) { partialSM(pB0, pB1, m_reg, mnB, alB); RESC(alB); finishSM(pB0, pB1, alB, l_reg, pa0, pa1, pa2, pa3); SBAR(); pv_d0<1>(o, vb0, pa0, pa1, pa2, pa3); }
    if (hi == 0) li_l[r32] = l_reg; asm volatile("s_waitcnt lgkmcnt(0)" ::: "memory");
    float rli[16];
#pragma unroll
    for (int r = 0; r < 16; ++r) rli[r] = __builtin_amdgcn_rcpf(li_l[crow(r, hi)]);
    float* Ow = Ob + (size_t)(wq * 32) * 2048 + vh * 128;
#pragma unroll
    for (int r = 0; r < 16; ++r) { const int orow = crow(r, hi);
#pragma unroll
        for (int d0 = 0; d0 < 4; ++d0) Ow[(size_t)orow * 2048 + d0 * 32 + r32] = o[d0][r] * rli[r]; }
    __syncthreads();
#undef SLOAD
#undef SWRITE
}
template <int OFF> __device__ __forceinline__ void tr_read8(s16x4 (&v)[8], int vb) {
    v[0] = tr_read<OFF>(vb); v[1] = tr_read<OFF + 2048>(vb); v[2] = tr_read<OFF + 4096>(vb); v[3] = tr_read<OFF + 6144>(vb);
    v[4] = tr_read<OFF + 8192>(vb); v[5] = tr_read<OFF + 10240>(vb); v[6] = tr_read<OFF + 12288>(vb); v[7] = tr_read<OFF + 14336>(vb);
}
#define PKV(L, H) (bf16x8){L[0], L[1], L[2], L[3], H[0], H[1], H[2], H[3]}
#define PV_MMA(od, v) do { od = __builtin_amdgcn_mfma_f32_32x32x16_bf16(pa0, PKV(v[0], v[1]), od, 0, 0, 0); od = __builtin_amdgcn_mfma_f32_32x32x16_bf16(pa1, PKV(v[2], v[3]), od, 0, 0, 0); \
    od = __builtin_amdgcn_mfma_f32_32x32x16_bf16(pa2, PKV(v[4], v[5]), od, 0, 0, 0); od = __builtin_amdgcn_mfma_f32_32x32x16_bf16(pa3, PKV(v[6], v[7]), od, 0, 0, 0); } while (0)
#define PV_OFF(VB, D0) ((VB) * 32768 + ((D0) >> 2) * 16384 + ((D0) & 3) * 512)
template <int VB> __device__ __forceinline__ void pv8(f32x16 (&o)[8], int vb, bf16x8 pa0, bf16x8 pa1, bf16x8 pa2, bf16x8 pa3) {
    s16x4 va[8], vbb[8];
    tr_read8<PV_OFF(VB, 0)>(va, vb);
    tr_read8<PV_OFF(VB, 1)>(vbb, vb); asm volatile("s_waitcnt lgkmcnt(8)" ::: "memory"); SBAR(); PV_MMA(o[0], va);
    tr_read8<PV_OFF(VB, 2)>(va, vb);  asm volatile("s_waitcnt lgkmcnt(8)" ::: "memory"); SBAR(); PV_MMA(o[1], vbb);
    tr_read8<PV_OFF(VB, 3)>(vbb, vb); asm volatile("s_waitcnt lgkmcnt(8)" ::: "memory"); SBAR(); PV_MMA(o[2], va);
    tr_read8<PV_OFF(VB, 4)>(va, vb);  asm volatile("s_waitcnt lgkmcnt(8)" ::: "memory"); SBAR(); PV_MMA(o[3], vbb);
    tr_read8<PV_OFF(VB, 5)>(vbb, vb); asm volatile("s_waitcnt lgkmcnt(8)" ::: "memory"); SBAR(); PV_MMA(o[4], va);
    tr_read8<PV_OFF(VB, 6)>(va, vb);  asm volatile("s_waitcnt lgkmcnt(8)" ::: "memory"); SBAR(); PV_MMA(o[5], vbb);
    tr_read8<PV_OFF(VB, 7)>(vbb, vb); asm volatile("s_waitcnt lgkmcnt(8)" ::: "memory"); SBAR(); PV_MMA(o[6], va);
    asm volatile("s_waitcnt lgkmcnt(0)" ::: "memory"); SBAR(); PV_MMA(o[7], vbb);
}
#undef PKV
#undef PV_MMA
#undef PV_OFF
__device__ __forceinline__ void attnA2_body(const bf16* __restrict__ Qb, const bf16* __restrict__ Kh, const bf16* __restrict__ Vh, float* __restrict__ Ob, int NT, float shiftC, LAS char* lds, int tid_) {
    int tid = tid_; asm volatile("" : "+v"(tid));
    const int wid = __builtin_amdgcn_readfirstlane(tid >> 6), lane = tid & 63, r32 = lane & 31, hi = lane >> 5, rg = wid & 3;
    const bool isS = wid < 4, skip_last = rg < 2;
    LAS char* K_lds = lds; LAS char* V_lds = lds + 32768; LAS char* P_l = lds + 98304 + rg * 4096 + lane * 16;
    LAS float* al_l = (LAS float*)(lds + pg8::XCH_OFF) + rg * 32; LAS unsigned* fl_l = (LAS unsigned*)(lds + pg8::XCH_OFF + 1024) + rg; LAS float* li_l = (LAS float*)(lds + pg8::XCH_OFF + 2048) + rg * 32;
    if (isS) {
        float m_reg = -1e30f, l_reg = 0.f; bf16x8 qr[8];
        const unsigned lq_ = (unsigned)lane >> 4, lc_ = (unsigned)lane & 15u, r8_ = ((unsigned)lane & 31u) >> 2;
        const unsigned kofE = lq_ * 2048u + ((lc_ ^ lq_) << 4), kofO = lq_ * 2048u + ((lc_ ^ (lq_ + 4u)) << 4);
        const unsigned vofL = ((r8_ >> 2) * 8u + (r8_ & 3u)) * 2048u + ((unsigned)lane >> 5) * 64u + ((unsigned)lane & 3u) * 16u;
#define A2_DMAK(t_, b) do { _Pragma("unroll") for (int q_ = 0; q_ < 4; ++q_) { const int i_ = 4 * rg + q_; \
            __builtin_amdgcn_global_load_lds((const unsigned*)((const char*)Kh + ((unsigned)(t_) * (64u * 2048u) + (unsigned)i_ * (4u * 2048u) + ((q_ & 1) ? kofO : kofE))), (LAS unsigned*)(K_lds + (b) * 16384 + i_ * 1024), 16, 0, 0); } } while (0)
#define A2_DMAV(t_, b) do { _Pragma("unroll") for (int q_ = 0; q_ < 8; ++q_) { const int j_ = 8 * rg + q_, J_ = 4 * (rg & 1) + (q_ >> 1); \
            const unsigned po_ = (unsigned)((J_ >> 1) * 16 + (J_ & 1) * 4) * 2048u + (unsigned)(q_ & 1) * 128u + (unsigned)(rg >> 1) * 256u; \
            __builtin_amdgcn_global_load_lds((const unsigned*)((const char*)Vh + ((unsigned)(t_) * (64u * 2048u) + po_ + vofL)), (LAS unsigned*)(V_lds + (b) * 32768 + j_ * 1024), 16, 0, 0); } } while (0)
#define A2_STAGE(PAR, t_) do { if ((t_) + 1 < NT) A2_DMAK((t_) + 1, (PAR) ^ 1); if ((t_) < NT) A2_DMAV((t_), PAR); } while (0)
#define A2_LANDED() asm volatile("s_waitcnt vmcnt(0)" ::: "memory")
        A2_DMAK(0, 0);
        const bf16* Qw = Qb + (size_t)(rg * 32 + r32) * 1024 + hi * 8;
#pragma unroll
        for (int d0 = 0; d0 < 8; ++d0) qr[d0] = ld8(Qw + d0 * 16);
        A2_LANDED();
        __syncthreads();
#define A2_SSTEP_FAST(PAR, t_) do { A2_STAGE(PAR, t_); \
        if ((t_) < NT && !(skip_last && (t_) == NT - 1)) { f32x16 p0, p1; bf16x8 pa0, pa1, pa2, pa3; constexpr float C = SM_SCALE * LOG2E; \
            qkt<PAR>(p0, p1, K_lds, qr, r32, hi); \
            _Pragma("unroll") for (int r = 0; r < 16; ++r) { p0[r] = __builtin_amdgcn_exp2f(fmaf(p0[r], C, -shiftC)); p1[r] = __builtin_amdgcn_exp2f(fmaf(p1[r], C, -shiftC)); } \
            finishSM_noexp(p0, p1, l_reg, pa0, pa1, pa2, pa3); \
            *(LAS bf16x8*)(P_l + (PAR) * 16384) = pa0; *(LAS bf16x8*)(P_l + (PAR) * 16384 + 1024) = pa1; *(LAS bf16x8*)(P_l + (PAR) * 16384 + 2048) = pa2; *(LAS bf16x8*)(P_l + (PAR) * 16384 + 3072) = pa3; } \
        if ((t_) == NT && hi == 0) li_l[r32] = __builtin_amdgcn_rcpf(l_reg); \
        A2_LANDED(); __syncthreads(); } while (0)
#define A2_SSTEP(PAR, t_) do { A2_STAGE(PAR, t_); \
        if ((t_) < NT && !(skip_last && (t_) == NT - 1)) { f32x16 p0, p1; float mn, alpha; bf16x8 pa0, pa1, pa2, pa3; \
            qkt<PAR>(p0, p1, K_lds, qr, r32, hi); partialSM(p0, p1, m_reg, mn, alpha); finishSM(p0, p1, alpha, l_reg, pa0, pa1, pa2, pa3); \
            *(LAS bf16x8*)(P_l + (PAR) * 16384) = pa0; *(LAS bf16x8*)(P_l + (PAR) * 16384 + 1024) = pa1; *(LAS bf16x8*)(P_l + (PAR) * 16384 + 2048) = pa2; *(LAS bf16x8*)(P_l + (PAR) * 16384 + 3072) = pa3; \
            const bool resc = __any(alpha < 1.f); if (resc && hi == 0) al_l[(PAR) * 128 + r32] = alpha; if (lane == 0) fl_l[(PAR) * 4] = resc ? 1u : 0u; } \
        if ((t_) == NT && hi == 0) li_l[r32] = __builtin_amdgcn_rcpf(l_reg); \
        A2_LANDED(); __syncthreads(); } while (0)
        if (shiftC > 0.f) { for (int t = 0; t <= NT; t += 2) { A2_SSTEP_FAST(0, t); if (t + 1 <= NT) A2_SSTEP_FAST(1, t + 1); } }
        else { for (int t = 0; t <= NT; t += 2) { A2_SSTEP(0, t); if (t + 1 <= NT) A2_SSTEP(1, t + 1); } }
#undef A2_SSTEP
#undef A2_SSTEP_FAST
#undef A2_STAGE
#undef A2_LANDED
#undef A2_DMAK
#undef A2_DMAV
    } else {
        f32x16 o[8];
#pragma unroll
        for (int d = 0; d < 8; ++d)
#pragma unroll
            for (int i = 0; i < 16; ++i) o[d][i] = 0.f;
        const int vb0 = (int)(uintptr_t)V_lds + v_rd_base(lane);
        __syncthreads();
#define A2_PSTEP(PAR, t_) do { \
        if ((t_) >= 1 && !(skip_last && (t_) == NT)) { constexpr int PJ = (PAR) ^ 1; \
            const bf16x8 pa0 = *(const LAS bf16x8*)(P_l + PJ * 16384), pa1 = *(const LAS bf16x8*)(P_l + PJ * 16384 + 1024), pa2 = *(const LAS bf16x8*)(P_l + PJ * 16384 + 2048), pa3 = *(const LAS bf16x8*)(P_l + PJ * 16384 + 3072); \
            if (shiftC <= 0.f && __builtin_amdgcn_readfirstlane((int)fl_l[PJ * 4]) != 0) { \
                _Pragma("unroll") for (int r = 0; r < 16; ++r) { const float a = al_l[PJ * 128 + crow(r, hi)]; _Pragma("unroll") for (int d = 0; d < 8; ++d) o[d][r] *= a; } } \
            asm volatile("" :: "v"(pa0), "v"(pa1), "v"(pa2), "v"(pa3));     \
            pv8<PJ>(o, vb0, pa0, pa1, pa2, pa3); } \
        __syncthreads(); } while (0)
        for (int t = 0; t <= NT; t += 2) { A2_PSTEP(0, t); if (t + 1 <= NT) A2_PSTEP(1, t + 1); }
#undef A2_PSTEP
        float rli[16];
#pragma unroll
        for (int r = 0; r < 16; ++r) rli[r] = li_l[crow(r, hi)];
        float* Ow = Ob + (size_t)(rg * 32) * 2048;
#pragma unroll
        for (int r = 0; r < 16; ++r) { const int orow = crow(r, hi);
#pragma unroll
            for (int d0 = 0; d0 < 8; ++d0) Ow[(size_t)orow * 2048 + d0 * 32 + r32] = o[d0][r] * rli[r]; }
    }
    __syncthreads();
}
__device__ __forceinline__ void attnB_body(const bf16* __restrict__ Qb, const bf16* __restrict__ Kh, const bf16* __restrict__ Vh, bf16* __restrict__ Ob, int q0, LAS char* lds, int tid_) {
    int tid = tid_; asm volatile("" : "+v"(tid));
    const int wid = __builtin_amdgcn_readfirstlane(tid >> 6), lane = tid & 63, r32 = lane & 31, hi = lane >> 5;
    LAS char* V_lds = lds; LAS char* K_lds = lds + 65536; volatile LAS unsigned* flg = (volatile LAS unsigned*)(lds + 100352);
    f32x16 o[4]; bf16x8 qr[8];
#pragma unroll
    for (int d = 0; d < 4; ++d)
#pragma unroll
        for (int i = 0; i < 16; ++i) o[d][i] = 0.f;
    const bf16* Qw = Qb + (size_t)(wid * 32 + r32) * NIN + hi * 8;
#pragma unroll
    for (int d0 = 0; d0 < 8; ++d0) qr[d0] = ld8(Qw + d0 * 16);
    const int sr = tid >> 4, sc = (tid & 15) * 8, vst0 = v_st(sr, sc), vst1 = v_st(32 + sr, sc);
    const int vb0 = (int)(uintptr_t)V_lds + v_rd_base(lane);
    const int qfirst = q0 + 32 * wid, qpos = qfirst + r32;
    bf16x8 ks0, ks1, v00, v10;
    const unsigned kvof = (unsigned)(sr * NIN + sc) * 2u;
#define SLOAD(k0) do { const unsigned kk_ = kvof + (unsigned)(k0) * (NIN * 2u); ks0 = LDG(Kh, kk_); ks1 = LDG(Kh, kk_ + 32u * NIN * 2u); v00 = LDG(Vh, kk_); v10 = LDG(Vh, kk_ + 32u * NIN * 2u); } while (0)
#define SWRITE(b) do { *(LAS bf16x8*)(V_lds + (b) * 32768 + vst0) = v00; *(LAS bf16x8*)(V_lds + (b) * 32768 + vst1) = v10; \
    *(LAS bf16x8*)(K_lds + (b) * 16384 + KSWZ(sr, sc * 2)) = ks0; *(LAS bf16x8*)(K_lds + (b) * 16384 + KSWZ(32 + sr, sc * 2)) = ks1; } while (0)
    float carry = 1.f; bool wdone = false;
    const int t_hi = (q0 + 255) >> 6;
    SLOAD(t_hi * 64); SWAIT(); SWRITE(0); __syncthreads();
#define BSTEP(CUR) { \
        if (t > 0) SLOAD((t - 1) * 64); \
        if (!wdone && 64 * t < qfirst + 31) {                \
            f32x16 p0, p1; qkt<CUR>(p0, p1, K_lds, qr, r32, hi); \
            if (64 * t + 63 >= qfirst) { stick32<true>(p1, 64 * t + 32, qpos, hi, carry); stick32<true>(p0, 64 * t, qpos, hi, carry); } \
            else { stick32<false>(p1, 0, 0, hi, carry); stick32<false>(p0, 0, 0, hi, carry); } \
            bf16x8 pa0, pa1, pa2, pa3; PK4(p0, 0, pa0); PK4(p0, 8, pa1); PK4(p1, 0, pa2); PK4(p1, 8, pa3); \
            pv_d0<CUR>(o, vb0, pa0, pa1, pa2, pa3); \
            wdone = __all(carry < 1e-30f); \
        } \
        if (lane == 0) flg[CUR * 8 + wid] = wdone ? 1u : 0u; \
        if (t > 0) { SWAIT(); SWRITE(CUR ^ 1); } \
        __syncthreads(); \
        if (t == 0) break; \
        if (__all(flg[CUR * 8 + (lane & 7)] != 0u)) break; \
        --t; }
    for (int t = t_hi;;) { BSTEP(0) BSTEP(1) }
#undef BSTEP
    bf16* Ow = Ob + (size_t)(wid * 32) * 1024;
#pragma unroll
    for (int r = 0; r < 16; ++r) { const int orow = crow(r, hi);
#pragma unroll
        for (int d0 = 0; d0 < 4; ++d0) Ow[(size_t)orow * 1024 + d0 * 32 + r32] = (bf16)f2bf(o[d0][r]); }
    __syncthreads();
#undef SLOAD
#undef SWRITE
#undef SWAIT
#undef RESC
}
}

__device__ __forceinline__ void phase_attention(const Frame& F0, const Args& args, int l) {
    OPAQUE_FRAME(F);
    const bf16* proj = (const bf16*)(F.ws + WS_PROJ); const bf16* QA = (const bf16*)(F.ws + WS_QA); const bf16* KA = (const bf16*)(F.ws + WS_KA);
    float* OS = (float*)(F.ws + WS_OS); bf16* OB = (bf16*)(F.ws + WS_OB); const bf16* VA = (const bf16*)(F.ws + WS_VA);
    const int c = blockIdx.x;
    float shiftC;
    { float gqm = fmaxf(fabsf(FIN(12)[l * 128 + F.lane]), fabsf(FIN(12)[l * 128 + 64 + F.lane])), gkm = fmaxf(fabsf(FIN(13)[l * 128 + F.lane]), fabsf(FIN(13)[l * 128 + 64 + F.lane]));
      gqm = fmaxf(gqm, swz_xor<1>(gqm)); gqm = fmaxf(gqm, swz_xor<2>(gqm)); gqm = fmaxf(gqm, swz_xor<4>(gqm)); gqm = fmaxf(gqm, swz_xor<8>(gqm)); gqm = fmaxf(gqm, swz_xor<16>(gqm)); gqm = xor32_max(gqm);
      gkm = fmaxf(gkm, swz_xor<1>(gkm)); gkm = fmaxf(gkm, swz_xor<2>(gkm)); gkm = fmaxf(gkm, swz_xor<4>(gkm)); gkm = fmaxf(gkm, swz_xor<8>(gkm)); gkm = fmaxf(gkm, swz_xor<16>(gkm)); gkm = xor32_max(gkm);
      const float B = 11.3137085f * 1.01f * gqm * gkm; shiftC = (B <= 30.f) ? B * LOG2E : 0.f; shiftC = __builtin_bit_cast(float, __builtin_amdgcn_readfirstlane(__builtin_bit_cast(int, shiftC))); }
#pragma unroll 1
    for (int st = 0; st < 4; ++st) {
        const int sel = (c & 1) ? ((st + 3) & 3) : st;
        if (sel == 0) {
            float* SPO = (float*)(F.ws + WS_PS); float* SPM = SPO + (size_t)MS * 8 * 4 * 256;
            for (int it = c; it < 256; it += F.G) {
                const int QQ = it & 3, x = (it >> 2) & 7, b = it >> 5, m0 = MP + 32 * b; const size_t crow0 = ((size_t)(l * DECB + b) * PAST) * 1024, nrow0 = (size_t)(32 * b) * 1024;
                const SampleKV kv{FIN(2) + crow0 + x * 128, FIN(3) + crow0 + (x >> 1) * 256, skn(F, l, 0) + nrow0 + x * 128, skn(F, l, 1) + nrow0 + (x >> 1) * 256};
                const size_t pi = ((size_t)(32 * b) * 8 + x) * 4 + QQ;
                sampleA_item(QA + (size_t)m0 * 1024 + x * 128, kv, QQ, SPO + pi * 256, SPM + pi * 2, F.lds, F.tid);
            }
        } else if (sel == 1) {
            for (int it = c; it < 64; it += F.G) {
                const int b = it >> 3, x = it & 7, m0 = MP + 32 * b; const size_t crow0 = ((size_t)(l * DECB + b) * PAST) * 1024, nrow0 = (size_t)(32 * b) * 1024;
                const SampleKV kv{FIN(4) + crow0 + x * 128, FIN(5) + crow0 + x * 128, skn(F, l, 2) + nrow0 + x * 128, skn(F, l, 3) + nrow0 + x * 128};
                sampleB_item(proj + (size_t)m0 * NIN + C_QB + x * 128, kv, OB + (size_t)m0 * 1024 + x * 128, F.lds, F.tid);
            }
        } else if (sel == 2) {
            for (int it = c; it < 256; it += F.G) {
                const int s = it & 7, bp = it >> 3;
        #pragma unroll 1
                for (int k = 0; k < 2; ++k) { const int qb = k == 0 ? 63 - bp : bp; const int m0 = 128 * qb;
                    att::attnA2_body(QA + (size_t)m0 * 1024 + s * 128, KA + s * 128, VA + (s >> 1) * 256, OS + (size_t)m0 * 2048 + s * 256, 2 * qb + 2, shiftC, (LAS char*)F.lds, F.tid); }
            }
        } else {
            for (int it = c; it < 256; it += F.G) {
                const int hd = it & 7, qb = it >> 3, m0 = 256 * qb;
                att::attnB_body(proj + (size_t)m0 * NIN + C_QB + hd * 128, proj + C_KB + hd * 128, proj + C_VB + hd * 128, OB + (size_t)m0 * 1024 + hd * 128, m0, (LAS char*)F.lds, F.tid);
            }
        }
    }
}

__device__ __forceinline__ float lam_of(Frame& F, const Args& args, int l) {
    const float a = wave_sum(FIN(14)[l * 128 + F.lane] * FIN(15)[l * 128 + F.lane] + FIN(14)[l * 128 + 64 + F.lane] * FIN(15)[l * 128 + 64 + F.lane]);
    const float b = wave_sum(FIN(16)[l * 128 + F.lane] * FIN(17)[l * 128 + F.lane] + FIN(16)[l * 128 + 64 + F.lane] * FIN(17)[l * 128 + 64 + F.lane]);
    const float lam_init = (l == 0) ? 0.2f : 0.35550906759096934f;
    return __expf(a) - __expf(b) + lam_init;
}
__device__ __forceinline__ void phase_combine(const Frame& F0, const Args& args, int l) {
    OPAQUE_FRAME(F);
    const float* OS = (const float*)(F.ws + WS_OS); bf16* OA = (bf16*)(F.ws + WS_OA);
    const float lam = lam_of(F, args, l), post = 1.0f - ((l == 0) ? 0.2f : 0.35550906759096934f);
    const f32x4 g = *(const f32x4*)(FIN(18) + l * 256 + 4 * F.lane);
    for (int it0 = F.gw; it0 < MP * 4; it0 += 4 * F.NGW) {
        f32x4 a[4], b[4];
#pragma unroll
        for (int q = 0; q < 4; ++q) { const int it = it0 + q * F.NGW; if (it < MP * 4) { const int m = it >> 2, hA = it & 3;
            a[q] = *(const f32x4*)(OS + (size_t)m * 2048 + (2 * hA) * 256 + 4 * F.lane); b[q] = *(const f32x4*)(OS + (size_t)m * 2048 + (2 * hA + 1) * 256 + 4 * F.lane); } else { a[q] = (f32x4){0.f, 0.f, 0.f, 0.f}; b[q] = a[q]; } }
#pragma unroll
        for (int q = 0; q < 4; ++q) { const int it = it0 + q * F.NGW; const int m = it >> 2, hA = it & 3;
            const f32x4 d = a[q] - b[q] * lam; const float ss = wave_sum((d[0] * d[0] + d[1] * d[1]) + (d[2] * d[2] + d[3] * d[3]));
            const float r = post / sqrtf(ss * (1.0f / 256) + EPS);
            u32x2 w; w.x = pk2(d[0] * r * g[0], d[1] * r * g[1]); w.y = pk2(d[2] * r * g[2], d[3] * r * g[3]);
            if (it < MP * 4) *(u32x2*)(OA + (size_t)m * 1024 + hA * 256 + 4 * F.lane) = w; }
    }
    const float* SPO = (const float*)(F.ws + WS_PS); const float* SPM = SPO + (size_t)MS * 8 * 4 * 256; const float C = SM_SCALE * LOG2E;
    for (int it = F.gw; it < MS * 4; it += F.NGW) { const int sm = it >> 2, hA = it & 3; f32x4 ab[2];
        f32x4 o[2][4]; float mm[2][4], ll[2][4];
#pragma unroll
        for (int e = 0; e < 2; ++e)
#pragma unroll
            for (int j = 0; j < 4; ++j) { const size_t pi = ((size_t)sm * 8 + 2 * hA + e) * 4 + j; o[e][j] = *(const f32x4*)(SPO + pi * 256 + 4 * F.lane); mm[e][j] = SPM[pi * 2]; ll[e][j] = SPM[pi * 2 + 1]; }
#pragma unroll
        for (int e = 0; e < 2; ++e) { const float Mx = fmaxf(fmaxf(mm[e][0], mm[e][1]), fmaxf(mm[e][2], mm[e][3])); float L = 0.f; f32x4 acc = {0.f, 0.f, 0.f, 0.f};
#pragma unroll
            for (int j = 0; j < 4; ++j) { const float w = __builtin_amdgcn_exp2f((mm[e][j] - Mx) * C); L += w * ll[e][j]; acc += o[e][j] * w; }
            ab[e] = acc * (1.0f / L); }
        const f32x4 d = ab[0] - ab[1] * lam; const float ss = wave_sum((d[0] * d[0] + d[1] * d[1]) + (d[2] * d[2] + d[3] * d[3]));
        const float r = post / sqrtf(ss * (1.0f / 256) + EPS);
        u32x2 w; w.x = pk2(d[0] * r * g[0], d[1] * r * g[1]); w.y = pk2(d[2] * r * g[2], d[3] * r * g[3]);
        *(u32x2*)(OA + (size_t)(MP + sm) * 1024 + hA * 256 + 4 * F.lane) = w; }
}

__device__ __forceinline__ void sample_down_in_gu(const Frame& F, unsigned* flg, const bf16* HID, const bf16* WD, float* XS) {
    const int r = 1452 % F.G, first = r, nI = F.G - first, ci = (int)blockIdx.x - first;
    if (ci < 0 || ci >= 32) return;
    if (F.tid == 0) { unsigned sp = 0; while (xb_ld(flg) < 44u) { __builtin_amdgcn_s_sleep(2); if (++sp > (1u << 24)) break; } __builtin_amdgcn_fence(__ATOMIC_ACQUIRE, "agent"); }
    __syncthreads();
    pg8::Gemm g{HID, WD, DFF}; pg8::SampleDownOrder S{nI, ci}; pg8::EpiResAdd E{0.5f, XS, (const float*)nullptr, (float*)nullptr, (bf16*)nullptr}; pg8::gemm_phase(F.lds, g, S, E);
}

constexpr int PH_PER_LAYER = 14, N_PHASES = 1 + DEPTH * PH_PER_LAYER;
__global__ void __launch_bounds__(NWAVES * 64, 2) mk_fwd(Args args) {
    extern __shared__ __attribute__((aligned(16))) unsigned char lds_[];
    Frame F; F.lds = (LAS unsigned char*)lds_;
    F.tid = threadIdx.x; F.lane = F.tid & 63; F.wave = __builtin_amdgcn_readfirstlane(F.tid >> 6); F.G = gridDim.x;
    F.gw = blockIdx.x * NWAVES + F.wave; F.NGW = F.G * NWAVES;
    F.out = args.out; F.ws = args.ws;
    volatile LAS unsigned* MISC = (volatile LAS unsigned*)(F.lds + MISC_OFF);
    if (F.tid < 32) MISC[F.tid] = 0u;
    __syncthreads();
    unsigned* ctl = (unsigned*)(F.ws + WS_CTL);
    XcdBarrier bar; bar.bar = ctl + CW_BAR; bar.x = 0; bar.st = nullptr;
    if (!MK_PER_PHASE) bar = xcd_barrier_post(ctl + CW_BAR, MISC + 8);
    const int lo = args.ph_lo, hi = args.ph_hi;
#ifndef PROBE_MASK
#define PROBE_MASK 0
#endif
#define PRB(j) ((PROBE_MASK >> (j)) & 1)
#define XBAR() do { if (!MK_PER_PHASE) xcd_barrier(bar); } while (0)
#define IN(k) (lo <= (k) && (k) < hi)
#define SEAM(k) do { if (!MK_PER_PHASE && IN(k) && IN((k) + 1)) xcd_barrier(bar); } while (0)
    if (IN(0)) { phase_prologue(F, args); }
#define OPQ(w) size_t z_ = 0; asm volatile("" : "+s"(z_)); unsigned char* w = F.ws + z_; float* xo = F.out + z_
#define LWP(w, off) ((bf16*)((w) + WS_W + (size_t)l * LW_SZ + (off)))
    for (int l = 0; l < DEPTH; ++l) {
        const int p0 = 1 + l * PH_PER_LAYER;
        if (IN(p0 + 0)) phase_rmsnorm(F, FIN(6) + l * DM, (bf16*)(F.ws + WS_H), l == 0 ? 0 : 4, l == 0 ? FIN(0) : (const float*)nullptr, l == 0 ? FIN(1) : F.out + (size_t)MP * DM);
        SEAM(p0 + 0);
        if (IN(p0 + 1)) { OPQ(w); unsigned* flg = ctl + CW_GUS + 64 * (2 * l + 0); pg8::Gemm g{(bf16*)(w + WS_H), LWP(w, LW_GU1), DM}; pg8::GuOrder S{F.G, (int)blockIdx.x, flg}; pg8::EpiSwiGLU E{(bf16*)(w + WS_HID), DFF}; pg8::gemm_phase(F.lds, g, S, E);
                           sample_down_in_gu(F, flg, (bf16*)(w + WS_HID), LWP(w, LW_D1), (float*)(w + WS_XS)); }
        SEAM(p0 + 1);
        if (IN(p0 + 2)) { OPQ(w); pg8::Gemm g{(bf16*)(w + WS_HID), LWP(w, LW_D1), DFF}; pg8::PanelOrder S; S.init(DM, DFF, F.G, (int)blockIdx.x, 0); pg8::EpiResAdd E{0.5f, (float*)(w + WS_XS), l == 0 ? FIN(0) : (const float*)nullptr, (float*)nullptr, (bf16*)(w + WS_XB)}; pg8::gemm_phase(F.lds, g, S, E); }
        SEAM(p0 + 2);
        if (IN(p0 + 3)) phase_rmsnorm(F, FIN(10) + l * DM, (bf16*)(F.ws + WS_H), 4, (const float*)nullptr, l == 0 ? FIN(1) : F.out + (size_t)MP * DM);
        SEAM(p0 + 3);
        if (IN(p0 + 4)) { OPQ(w); pg8::Gemm g{(bf16*)(w + WS_H), LWP(w, LW_IN), DM}; pg8::PanelOrder S; S.init(NIN, DM, F.G, (int)blockIdx.x, 4); pg8::EpiProj E{(bf16*)(w + WS_PROJ), (float*)(w + WS_PS), (bf16*)(w + WS_QA), (bf16*)(w + WS_KA), (bf16*)(w + WS_VA), xo, FIN(12) + l * 128, FIN(13) + l * 128, (const float2*)(w + WS_TAB), l, F.lds}; pg8::gemm_phase(F.lds, g, S, E); }
        SEAM(p0 + 4);
        if (IN(p0 + 5)) phase_rope(F, args, l);
        SEAM(p0 + 5);
        if (IN(p0 + 6)) phase_attention(F, args, l);
        SEAM(p0 + 6);
        if (IN(p0 + 7)) phase_combine(F, args, l);
        SEAM(p0 + 7);
        if (IN(p0 + 8)) { OPQ(w); pg8::Gemm g{(bf16*)(w + WS_OA), LWP(w, LW_BR), 1024}; pg8::BranchOrder S{F.G, (int)blockIdx.x}; pg8::EpiBranch E{(bf16*)(w + WS_PROJ), (bf16*)(w + WS_MRG)}; pg8::gemm_phase(F.lds, g, S, E);
                           pg8::SampleBranchOrder S2{F.G, (int)blockIdx.x}; pg8::EpiGateSlab E2{(bf16*)(w + WS_PROJ), (float*)(w + WS_XS)}; pg8::gemm_phase(F.lds, g, S2, E2); }
        SEAM(p0 + 8);
        if (IN(p0 + 9)) phase_merge_sample(F);
        SEAM(p0 + 9);
        if (IN(p0 + 10)) { OPQ(w); pg8::Gemm g{(bf16*)(w + WS_MRG), LWP(w, LW_O), DM}; pg8::PanelOrder S; S.init(DM, DM, F.G, (int)blockIdx.x, 4); pg8::EpiResAdd E{1.0f, (float*)(w + WS_XS), (const float*)nullptr, (float*)nullptr, (bf16*)(w + WS_XB)}; pg8::gemm_phase(F.lds, g, S, E); }
        SEAM(p0 + 10);
        if (IN(p0 + 11)) phase_rmsnorm(F, FIN(22) + l * DM, (bf16*)(F.ws + WS_H), 4, (const float*)nullptr, F.out + (size_t)MP * DM);
        SEAM(p0 + 11);
        if (IN(p0 + 12)) { OPQ(w); unsigned* flg = ctl + CW_GUS + 64 * (2 * l + 1); pg8::Gemm g{(bf16*)(w + WS_H), LWP(w, LW_GU2), DM}; pg8::GuOrder S{F.G, (int)blockIdx.x, flg}; pg8::EpiSwiGLU E{(bf16*)(w + WS_HID), DFF}; pg8::gemm_phase(F.lds, g, S, E);
                           sample_down_in_gu(F, flg, (bf16*)(w + WS_HID), LWP(w, LW_D2), (float*)(w + WS_XS)); }
        SEAM(p0 + 12);
        if (IN(p0 + 13)) { if (l + 1 == DEPTH) phase_final(F);
                           OPQ(w); pg8::Gemm g{(bf16*)(w + WS_HID), LWP(w, LW_D2), DFF}; pg8::PanelOrder S; S.init(DM, DFF, F.G, (int)blockIdx.x, 0); pg8::EpiResAdd E{0.5f, (float*)(w + WS_XS), (const float*)nullptr, (l + 1 == DEPTH) ? xo : (float*)nullptr, (bf16*)(w + WS_XB)}; pg8::gemm_phase(F.lds, g, S, E); }
        SEAM(p0 + 13);
    }
#undef IN
#undef SEAM
}

extern "C" void kernel_launch(void* const* d_in, const int* in_sizes, int n_in, void* d_out, int out_size, void* d_ws, size_t ws_size, hipStream_t stream) {
    static int grid = 0;
    if (grid == 0) {
        if (n_in != 26 || (size_t)out_size != O_END || ws_size < WS_END) { fprintf(stderr, "kernel_launch: shape mismatch: n_in %d out %d ws %zu (need %zu)\n", n_in, out_size, ws_size, (size_t)WS_END); grid = -1; return; }
        int dev = 0, cus = 0, per_cu = 0;
        if (hipGetDevice(&dev) != hipSuccess || hipDeviceGetAttribute(&cus, hipDeviceAttributeMultiprocessorCount, dev) != hipSuccess) { grid = -1; return; }
        if (hipFuncSetAttribute((const void*)mk_fwd, hipFuncAttributeMaxDynamicSharedMemorySize, LDS_BYTES) != hipSuccess) { fprintf(stderr, "kernel_launch: hipFuncSetAttribute failed\n"); grid = -1; return; }
        if (hipOccupancyMaxActiveBlocksPerMultiprocessor(&per_cu, (const void*)mk_fwd, NWAVES * 64, LDS_BYTES) != hipSuccess || per_cu < 1) fprintf(stderr, "kernel_launch: occupancy query says %d\n", per_cu);
        (void)hipGetLastError();
        grid = cus;
    }
    if (grid < 0) return;
    (void)in_sizes;
    if (hipMemsetAsync((char*)d_ws + WS_CTL, 0, CTL_BYTES, stream) != hipSuccess) { fprintf(stderr, "kernel_launch: memset failed\n"); return; }
    Args a{};
    for (int i = 0; i < 26; ++i) a.in[i] = (const float*)d_in[i];
    a.out = (float*)d_out; a.ws = (unsigned char*)d_ws;
#if MK_PER_PHASE
    for (int p = 0; p < N_PHASES; ++p) { a.ph_lo = p; a.ph_hi = p + 1; hipLaunchKernelGGL(mk_fwd, dim3(grid), dim3(NWAVES * 64), LDS_BYTES, stream, a); }
#else
    a.ph_lo = 0; a.ph_hi = N_PHASES;
    hipLaunchKernelGGL(mk_fwd, dim3(grid), dim3(NWAVES * 64), LDS_BYTES, stream, a);
#endif
    const hipError_t le = hipPeekAtLastError();
    if (le != hipSuccess) fprintf(stderr, "kernel_launch: launch failed: %s\n", hipGetErrorName(le));
}
```
